# Optimizing an MI355X kernel written in HIP

```python
import math
import jax, jax.numpy as jnp
from jax import lax
import numpy as np

D_MODEL = 1024
BATCH = 16
SEQ = 2048
DEPTH = 2

GRID_W = 64
CTX_LEN = 256
HEAD_DIM = 64
MIX_WIDTH = D_MODEL
FOURIER_GROUPS = 4
FOURIER_WIDTH = MIX_WIDTH // 4
FOURIER_GROUP_DIM = FOURIER_WIDTH // FOURIER_GROUPS
GQA_HEADS = (MIX_WIDTH // 2) // HEAD_DIM
GQA_KV_HEADS = GQA_HEADS // 4
NA_HEADS = (MIX_WIDTH // 4) // HEAD_DIM
NA_WIN_H = 8
NA_WIN_W = 16
Q_BLOCK = 128
ROPE_THETA = 10000.0
ROPE_PAIRS_PER_AXIS = HEAD_DIM // 4
D_FF = 256 * math.ceil(8 * D_MODEL / 3 / 256)
N_BRANCHES = 3
N_MOD = 9
EPS = 1e-6
GQA_Q_WIDTH = GQA_HEADS * HEAD_DIM
GQA_KV_WIDTH = GQA_KV_HEADS * HEAD_DIM
NA_WIDTH = NA_HEADS * HEAD_DIM
PROJ_SPLITS = tuple(int(v) for v in np.cumsum([FOURIER_WIDTH, GQA_Q_WIDTH, GQA_KV_WIDTH, GQA_KV_WIDTH, NA_WIDTH, NA_WIDTH, NA_WIDTH]))
IN_PROJ_WIDTH = PROJ_SPLITS[-1] + N_BRANCHES * D_MODEL

kernel_name = "hybrid_gated_mixer_dit_block"


def rms_norm(x, gain):
    xf = x.astype(jnp.float32)
    y = xf * lax.rsqrt(jnp.mean(xf * xf, axis=-1, keepdims=True) + EPS)
    return (y * gain.astype(jnp.float32)).astype(x.dtype)


def modulate(u, shift, scale):
    return u * (1 + scale) + shift


def swiglu(u, w_in, w_out):
    a, g = jnp.split(u @ w_in, 2, axis=-1)
    return (jax.nn.silu(g) * a) @ w_out


def heads(t, n):
    return t.reshape(t.shape[0], t.shape[1], n, HEAD_DIM)


def axial_rope_tables(seq_len):
    t = jnp.arange(seq_len)
    row = (t // GRID_W).astype(jnp.float32)
    col = (t % GRID_W).astype(jnp.float32)
    freqs = ROPE_THETA ** (-jnp.arange(ROPE_PAIRS_PER_AXIS, dtype=jnp.float32) / ROPE_PAIRS_PER_AXIS)
    ang = jnp.concatenate([row[:, None] * freqs, col[:, None] * freqs], axis=-1)
    return jnp.cos(ang), jnp.sin(ang)


def apply_rope(x, cos, sin):
    xf = x.astype(jnp.float32).reshape(*x.shape[:-1], HEAD_DIM // 2, 2)
    x0, x1 = xf[..., 0], xf[..., 1]
    c, s = cos[None, :, None, :], sin[None, :, None, :]
    out = jnp.stack([x0 * c - x1 * s, x0 * s + x1 * c], axis=-1)
    return out.reshape(x.shape).astype(x.dtype)


def fourier_mix(u):
    b, t, _ = u.shape
    ug = u.astype(jnp.float32).reshape(b, t, FOURIER_GROUPS, FOURIER_GROUP_DIM)
    y = jnp.fft.fft2(ug, axes=(1, 3), norm="ortho").real
    return y.reshape(b, t, FOURIER_WIDTH).astype(u.dtype)


def gqa_attend(q, k, v):
    b, t, h, hd = q.shape
    kvh = k.shape[2]
    qg = q.reshape(b, t, kvh, h // kvh, hd)
    s = jnp.einsum("btkgd,blkd->bkgtl", qg, k).astype(jnp.float32) * (hd ** -0.5)
    p = jax.nn.softmax(s, axis=-1).astype(v.dtype)
    o = jnp.einsum("bkgtl,blkd->btkgd", p, v)
    return o.reshape(b, t, h * hd)


def gqa_latent(q, k_all, v_all):
    b, s, h, hd = q.shape
    qb = jnp.moveaxis(q.reshape(b, s // Q_BLOCK, Q_BLOCK, h, hd), 1, 0)
    out = lax.map(lambda blk: gqa_attend(blk, k_all, v_all), qb)
    return jnp.moveaxis(out, 0, 1).reshape(b, s, h * hd)


def neighbourhood_attention(q, k, v, k_ctx, v_ctx, rpb):
    b, s, nh, hd = q.shape
    rows = s // GRID_W
    kh = min(NA_WIN_H, rows)
    qg = jnp.moveaxis(q.reshape(b, rows, GRID_W, nh, hd), 1, 0)
    kg = k.reshape(b, rows, GRID_W, nh, hd)
    vg = v.reshape(b, rows, GRID_W, nh, hd)
    col = jnp.arange(GRID_W)
    cs = jnp.clip(col - NA_WIN_W // 2, 0, GRID_W - NA_WIN_W)
    band = (col[None, :] >= cs[:, None]) & (col[None, :] < cs[:, None] + NA_WIN_W)
    dc = jnp.clip(col[None, :] - col[:, None], -(NA_WIN_W - 1), NA_WIN_W - 1) + NA_WIN_W - 1
    scale = hd ** -0.5

    def row_block(args):
        q_row, r = args
        rs = jnp.clip(r - kh // 2, 0, rows - kh)
        k_blk = lax.dynamic_slice_in_dim(kg, rs, kh, axis=1)
        v_blk = lax.dynamic_slice_in_dim(vg, rs, kh, axis=1)
        dr = rs + jnp.arange(kh) - r + NA_WIN_H - 1
        bias = rpb[:, dr[:, None, None], dc[None, :, :]]
        bias = jnp.transpose(bias, (0, 2, 1, 3)).astype(jnp.float32)
        s_loc = jnp.einsum("bqhd,bikhd->bhqik", q_row, k_blk).astype(jnp.float32) * scale + bias[None]
        s_loc = jnp.where(band[:, None, :], s_loc, -jnp.inf).reshape(b, nh, GRID_W, kh * GRID_W)
        s_ctx = jnp.einsum("bqhd,bjhd->bhqj", q_row, k_ctx).astype(jnp.float32) * scale
        p = jax.nn.softmax(jnp.concatenate([s_loc, s_ctx], axis=-1), axis=-1).astype(v.dtype)
        p_loc = p[..., : kh * GRID_W].reshape(b, nh, GRID_W, kh, GRID_W)
        p_ctx = p[..., kh * GRID_W:]
        return (jnp.einsum("bhqik,bikhd->bqhd", p_loc, v_blk)
                + jnp.einsum("bhqj,bjhd->bqhd", p_ctx, v_ctx))

    out = lax.map(row_block, (qg, jnp.arange(rows)))
    return jnp.moveaxis(out, 0, 1).reshape(b, s, nh * hd)


def gated_merge(gate_logits, y_f, y_g, y_n):
    g_f, g_g, g_n = jnp.split(jax.nn.sigmoid(gate_logits), N_BRANCHES, axis=-1)
    return g_f * y_f + g_g * y_g + g_n * y_n


def token_mixer(ux, uh, w_in, q_norm, k_norm, na_rpb, w_fourier, w_gqa_out, w_na_out, w_o, cos, sin, ctx_out):
    fx, gqx, gkx, gvx, nqx, nkx, nvx, gatex = jnp.split(ux @ w_in, PROJ_SPLITS, axis=-1)
    fh, gqh, gkh, gvh, nqh, nkh, nvh, gateh = jnp.split(uh @ w_in, PROJ_SPLITS, axis=-1)
    gk_h = rms_norm(heads(gkh, GQA_KV_HEADS), k_norm)
    gv_h = heads(gvh, GQA_KV_HEADS)
    nk_h = heads(nkh, NA_HEADS)
    nv_h = heads(nvh, NA_HEADS)
    y_f = fourier_mix(fx) @ w_fourier
    q = apply_rope(rms_norm(heads(gqx, GQA_HEADS), q_norm), cos, sin)
    k = apply_rope(rms_norm(heads(gkx, GQA_KV_HEADS), k_norm), cos, sin)
    v = heads(gvx, GQA_KV_HEADS)
    y_g = gqa_latent(q, jnp.concatenate([gk_h, k], axis=1), jnp.concatenate([gv_h, v], axis=1)) @ w_gqa_out
    y_n = neighbourhood_attention(heads(nqx, NA_HEADS), heads(nkx, NA_HEADS), heads(nvx, NA_HEADS), nk_h, nv_h, na_rpb) @ w_na_out
    yx = gated_merge(gatex, y_f, y_g, y_n) @ w_o
    if not ctx_out:
        return yx, None
    y_fh = fourier_mix(fh) @ w_fourier
    y_gh = gqa_attend(rms_norm(heads(gqh, GQA_HEADS), q_norm), gk_h, gv_h) @ w_gqa_out
    y_nh = gqa_attend(heads(nqh, NA_HEADS), nk_h, nv_h) @ w_na_out
    yh = gated_merge(gateh, y_fh, y_gh, y_nh) @ w_o
    return yx, yh


def setup_inputs(seed: int = 0) -> dict:
    key = jax.random.key(seed)
    ks = jax.random.split(key, 24)
    f32 = jnp.float32
    L, D = DEPTH, D_MODEL

    def w(k, shape, fan_in, gain=1.0):
        return (gain * fan_in ** -0.5) * jax.random.normal(k, shape, f32)

    def g(k, shape):
        return 1.0 + 0.02 * jax.random.normal(k, shape, f32)

    return {
        "x": jax.random.normal(ks[0], (BATCH, SEQ, D), f32),
        "c": jax.random.normal(ks[1], (BATCH, D), f32),
        "ctx": jax.random.normal(ks[2], (BATCH, CTX_LEN, D), f32),
        "c_ctx": jax.random.normal(ks[3], (D,), f32),
        "mod_w": w(ks[4], (L, D, N_MOD * D), D, 0.5),
        "mod_b": 0.01 * jax.random.normal(ks[5], (L, N_MOD * D), f32),
        "norm_ffn1": g(ks[6], (L, D)),
        "ffn1_w_in": w(ks[7], (L, D, 2 * D_FF), D),
        "ffn1_w_out": w(ks[8], (L, D_FF, D), D_FF),
        "norm_mix": g(ks[9], (L, D)),
        "w_in": w(ks[10], (L, D, IN_PROJ_WIDTH), D),
        "q_norm": g(ks[11], (L, HEAD_DIM)),
        "k_norm": g(ks[12], (L, HEAD_DIM)),
        "na_rpb": 0.1 * jax.random.normal(ks[13], (L, NA_HEADS, 2 * NA_WIN_H - 1, 2 * NA_WIN_W - 1), f32),
        "w_fourier": w(ks[14], (L, FOURIER_WIDTH, D), FOURIER_WIDTH),
        "w_gqa_out": w(ks[15], (L, GQA_Q_WIDTH, D), GQA_Q_WIDTH),
        "w_na_out": w(ks[16], (L, NA_WIDTH, D), NA_WIDTH),
        "w_o": w(ks[17], (L, D, D), D),
        "norm_ffn2": g(ks[18], (L, D)),
        "ffn2_w_in": w(ks[19], (L, D, 2 * D_FF), D),
        "ffn2_w_out": w(ks[20], (L, D_FF, D), D_FF),
        "final_norm": g(ks[21], (D,)),
    }


def reference(x, c, ctx, c_ctx, mod_w, mod_b, norm_ffn1, ffn1_w_in, ffn1_w_out, norm_mix, w_in, q_norm, k_norm, na_rpb, w_fourier, w_gqa_out, w_na_out, w_o, norm_ffn2, ffn2_w_in, ffn2_w_out, final_norm):
    cos, sin = axial_rope_tables(x.shape[1])
    h = ctx
    for l in range(DEPTH):
        last = l == DEPTH - 1
        mx = jnp.split((jax.nn.silu(c) @ mod_w[l] + mod_b[l])[:, None, :], N_MOD, axis=-1)
        mh = jnp.split((jax.nn.silu(c_ctx) @ mod_w[l] + mod_b[l])[None, None, :], N_MOD, axis=-1)
        x = x + 0.5 * mx[2] * swiglu(modulate(rms_norm(x, norm_ffn1[l]), mx[0], mx[1]), ffn1_w_in[l], ffn1_w_out[l])
        h = h + 0.5 * mh[2] * swiglu(modulate(rms_norm(h, norm_ffn1[l]), mh[0], mh[1]), ffn1_w_in[l], ffn1_w_out[l])
        ux = modulate(rms_norm(x, norm_mix[l]), mx[3], mx[4])
        uh = modulate(rms_norm(h, norm_mix[l]), mh[3], mh[4])
        yx, yh = token_mixer(ux, uh, w_in[l], q_norm[l], k_norm[l], na_rpb[l], w_fourier[l], w_gqa_out[l], w_na_out[l], w_o[l], cos, sin, not last)
        x = x + mx[5] * yx
        x = x + 0.5 * mx[8] * swiglu(modulate(rms_norm(x, norm_ffn2[l]), mx[6], mx[7]), ffn2_w_in[l], ffn2_w_out[l])
        if not last:
            h = h + mh[5] * yh
            h = h + 0.5 * mh[8] * swiglu(modulate(rms_norm(h, norm_ffn2[l]), mh[6], mh[7]), ffn2_w_in[l], ffn2_w_out[l])
    return rms_norm(x, final_norm)
```

```cpp
#include <hip/hip_runtime.h>
#include <hip/hip_cooperative_groups.h>
#include <cstdio>
#include <cstdint>
namespace cg = cooperative_groups;

#define LAS __attribute__((address_space(3)))
typedef unsigned short bf16_t;
typedef short bf16x8 __attribute__((ext_vector_type(8)));
typedef float f32x4 __attribute__((ext_vector_type(4)));
typedef float f32x16 __attribute__((ext_vector_type(16)));
typedef unsigned u32x4 __attribute__((ext_vector_type(4)));
typedef unsigned u32x2 __attribute__((ext_vector_type(2)));

constexpr int D = 1024, NBATCH = 16, SEQ = 2048, CTX = 256, TB = SEQ + CTX  , MT = NBATCH * TB  ;
constexpr int DFF = 2816, NMOD = 9216, NPROJ = 2048  , NGATE = 3072, PW = 1152  ;
constexpr int INW = 4864;
constexpr float EPS = 1e-6f;
constexpr float LOG2E = 1.4426950408889634f;
constexpr float QSCALE = 0.125f * LOG2E;

constexpr size_t MiB = 1u << 20;
constexpr size_t WS_CTL = 0;
constexpr size_t WS_MOD = 1 * MiB;
constexpr size_t WS_DFTC = 3 * MiB;
constexpr size_t WS_DFT = 4 * MiB;
constexpr size_t WS_W = 20 * MiB;
constexpr size_t W_FFN1_IN = WS_W, W_FFN1_OUT = W_FFN1_IN + 11 * MiB, W_FFN2_IN = W_FFN1_OUT + 11 * MiB / 2, W_FFN2_OUT = W_FFN2_IN + 11 * MiB;
constexpr size_t W_INP = W_FFN2_OUT + 11 * MiB / 2, W_GATE = W_INP + 4 * MiB, W_FOUR = W_GATE + 6 * MiB, W_GQAO = W_FOUR + MiB / 2, W_NAO = W_GQAO + MiB, W_O = W_NAO + MiB / 2;
constexpr size_t WS_XC = 67 * MiB;
constexpr size_t WS_U = 83 * MiB;
constexpr size_t WS_YF = 155 * MiB;
constexpr size_t WS_YG = 173 * MiB;
constexpr size_t WS_YN = 209 * MiB;
constexpr size_t WS_PQT = 227 * MiB;
constexpr size_t WS_PQTC = 259 * MiB;
constexpr size_t WS_VTG = 263 * MiB;
constexpr size_t WS_VTN = 272 * MiB;
constexpr size_t WS_BIG = 290 * MiB;
constexpr size_t WS_END = 506 * MiB;
static_assert(W_O + 2 * MiB <= WS_XC, "weights");
static_assert(WS_BIG + (size_t)MT * NGATE * 2 <= WS_END, "big");

constexpr int LDS_RING = 131072;
constexpr int LDS_RPB = LDS_RING + 256;
constexpr int LDS_BYTES = LDS_RPB + 4 * 15 * 32 * 4;

typedef float f32x2_t __attribute__((ext_vector_type(2))); typedef __bf16 bf16x2_t __attribute__((ext_vector_type(2)));
__device__ __forceinline__ unsigned cvt_pk_bf16(float lo, float hi) { const f32x2_t v = {lo, hi}; const bf16x2_t b = __builtin_convertvector(v, bf16x2_t); return __builtin_bit_cast(unsigned, b); }
__device__ __forceinline__ float bf2f(unsigned short b) { return __uint_as_float(((unsigned)b) << 16); }
__device__ __forceinline__ float bflo(unsigned w) { return __uint_as_float(w << 16); }
__device__ __forceinline__ float bfhi(unsigned w) { return __uint_as_float(w & 0xffff0000u); }
__device__ __forceinline__ float fexp2(float x) { return __builtin_amdgcn_exp2f(x); }
__device__ __forceinline__ float frcp(float x) { return __builtin_amdgcn_rcpf(x); }
__device__ __forceinline__ float sigmoidf_(float x) { return frcp(1.0f + fexp2(-x * LOG2E)); }
__device__ __forceinline__ float shx(float v, int m, int lane) { return __builtin_bit_cast(float, __builtin_amdgcn_ds_bpermute((lane ^ m) << 2, __builtin_bit_cast(int, v))); }
__device__ __forceinline__ float wave_sum(float v, int lane) {
#pragma unroll
    for (int o = 1; o < 64; o <<= 1) v += shx(v, o, lane);
    return v;
}
#define LDS_WAIT() asm volatile("s_waitcnt lgkmcnt(0)" ::: "memory")
__device__ __forceinline__ int opaque_tid(int wid) { int t; asm volatile("v_mbcnt_lo_u32_b32 %0, -1, 0\n\tv_mbcnt_hi_u32_b32 %0, -1, %0" : "=v"(t)); return wid * 64 + t; }

namespace pg8 {
constexpr int BM = 256, BK = 64, HALF = 128, HTB = HALF * BK * 2, NXCD = 8, WGM = 8;
__device__ __forceinline__ int lds_byte(int r, int c) { const int st = (r >> 4) * 2 + (c >> 5), rr = r & 15, cc = c & 31, ob = rr * 64 + cc * 2; return st * 1024 + (ob ^ (((ob >> 9) & 1) << 5)); }
__device__ __forceinline__ void stage_rc(int b, int& R, int& C) { const int st = b / 1024, sb = b % 1024, swz = sb ^ (((sb >> 9) & 1) << 5); R = (st >> 1) * 16 + swz / 64; C = (st & 1) * 32 + (swz % 64) / 2; }
__device__ __forceinline__ int perm32(int rho) { const int n = rho >> 4, i = rho & 15; return 8 * (i >> 2) + 4 * n + (i & 3); }
struct Unit { int pm, pn; };
struct Gemm { const bf16_t* A; const bf16_t* Bt; int M, N, K; };
struct StaticOrder {
    int nM, nN, nwg, G, c, lat;
    __device__ void init(int M, int N, int G_, int c_, int lat_ = 0) { lat = lat_; nM = lat ? (M / BM / 9) * 8 : M / BM; nN = N / BM; nwg = nM * nN; G = G_; c = c_; }
    __device__ bool next(int i, Unit& u) const {
        const long L = (long)i * G + c; if (L >= nwg) return false;
        int wgid = (int)L; { const int q = nwg / NXCD, r = nwg % NXCD, xcd = wgid % NXCD, off = wgid / NXCD; wgid = (xcd < r ? xcd * (q + 1) : r * (q + 1) + (xcd - r) * q) + off; }
        const int nig = WGM * nN, gid = wgid / nig, fm = gid * WGM, gsz = (nM - fm) < WGM ? (nM - fm) : WGM;
        u.pm = fm + ((wgid % nig) % gsz); u.pn = (wgid % nig) / gsz;
        if (lat) u.pm = (u.pm >> 3) * 9 + 1 + (u.pm & 7);
        return true;
    }
};
struct OneUnit {
    int pm, pn;
    __device__ bool next(int i, Unit& u) const { if (i) return false; u.pm = pm; u.pn = pn; return true; }
};

template <class Epi, class Sched>
__device__ __forceinline__ void gemm_phase(LAS unsigned char* lds, const Gemm g, const Sched& S, const Epi& E, const int wid) {
    const int tid = opaque_tid(wid), lane = tid & 63, wr = wid >> 2, wc = wid & 3, fr = lane & 15, fq = lane >> 4;
    const int K = g.K, nt = K / BK;
    unsigned voffA[2], voffB[2];
#pragma unroll
    for (int i = 0; i < 2; ++i) { int R, C; stage_rc(tid * 16 + i * 8192, R, C); const int Rb = Epi::PERM ? ((R & ~31) + perm32(R & 31)) : R;
        voffA[i] = (unsigned)(R * K + C) * 2u; voffB[i] = (unsigned)(Rb * K + C) * 2u; }
    const size_t kstep = (size_t)(BK * 2);
    const size_t hstep = (size_t)HALF * K * 2;
    const size_t tstep = 2 * hstep;
    const unsigned ldsw = (unsigned)wid * 1024u;
    const int aoff = lds_byte(wr * 64 + fr, fq * 8), boff = lds_byte(wc * 32 + fr, fq * 8);
#define PG8_SA(b, h) (((b) * 2 + (h)) * HTB)
#define PG8_SB(b, h) ((4 + (b) * 2 + (h)) * HTB)
#define PG8_STAGE(bufoff, gbase, voff) do { _Pragma("unroll") for (int _i = 0; _i < 2; ++_i) \
        __builtin_amdgcn_global_load_lds((const unsigned*)((const char*)(gbase) + (voff)[_i]), (LAS unsigned*)(lds + (bufoff) + ldsw + _i * 8192), 16, 0, 0); } while (0)
#define PG8_LDA(dst, b, h) do { _Pragma("unroll") for (int m = 0; m < 4; ++m) _Pragma("unroll") for (int k = 0; k < 2; ++k) dst[m][k] = *(const LAS bf16x8*)(lds + PG8_SA(b, h) + aoff + m * 2048 + k * 1024); } while (0)
#define PG8_LDB(dst, b, h) do { _Pragma("unroll") for (int n = 0; n < 2; ++n) _Pragma("unroll") for (int k = 0; k < 2; ++k) dst[n][k] = *(const LAS bf16x8*)(lds + PG8_SB(b, h) + boff + n * 2048 + k * 1024); } while (0)
#define PG8_MMA(ai, bj, At, Bt) do { __builtin_amdgcn_s_setprio(1); _Pragma("unroll") for (int m = 0; m < 4; ++m) _Pragma("unroll") for (int n = 0; n < 2; ++n) _Pragma("unroll") for (int k = 0; k < 2; ++k) \
        acc[ai][bj][m][n] = __builtin_amdgcn_mfma_f32_16x16x32_bf16(Bt[n][k], At[m][k], acc[ai][bj][m][n], 0, 0, 0); __builtin_amdgcn_s_setprio(0); } while (0)
#define PG8_WAIT_V(n) asm volatile("s_waitcnt vmcnt(" #n ")" ::: "memory")
#define PG8_WAIT_L(n) asm volatile("s_waitcnt lgkmcnt(" #n ")" ::: "memory")
#define PG8_BAR __builtin_amdgcn_s_barrier()
#define PG8_SCHED __builtin_amdgcn_sched_barrier(0)
    Unit cur, nxt; int ui = 0;
    if (!S.next(0, cur)) return;
    f32x4 acc[2][2][4][2];
#pragma unroll
    for (int a = 0; a < 2; ++a)
#pragma unroll
        for (int b = 0; b < 2; ++b)
#pragma unroll
            for (int m = 0; m < 4; ++m)
#pragma unroll
                for (int n = 0; n < 2; ++n) acc[a][b][m][n] = (f32x4){0.f, 0.f, 0.f, 0.f};
    bf16x8 At[4][2], B0[2][2], B1[2][2];
    const char* cA = (const char*)g.A + (size_t)cur.pm * tstep; const char* cB = (const char*)g.Bt + (size_t)cur.pn * tstep;
    PG8_STAGE(PG8_SB(0, 0), cB, voffB); PG8_STAGE(PG8_SB(0, 1), cB + hstep, voffB); PG8_STAGE(PG8_SA(0, 0), cA, voffA); PG8_STAGE(PG8_SA(0, 1), cA + hstep, voffA);
    if (wr == 1) PG8_BAR;
    PG8_WAIT_V(2); PG8_BAR;
    PG8_STAGE(PG8_SB(1, 0), cB + kstep, voffB); PG8_STAGE(PG8_SA(1, 0), cA + kstep, voffA); PG8_STAGE(PG8_SB(1, 1), cB + hstep + kstep, voffB);
    PG8_WAIT_V(6); PG8_BAR;
    for (;;) {
        const bool has_next = S.next(ui + 1, nxt);
        const char* nA = has_next ? (const char*)g.A + (size_t)nxt.pm * tstep : cA; const char* nB = has_next ? (const char*)g.Bt + (size_t)nxt.pn * tstep : cB;
        for (int t = 0; t < nt; t += 2) {
            const bool last = (t == nt - 2);
            const char* a1 = cA + (size_t)(t + 1) * kstep;
            const char* a2 = last ? nA : cA + (size_t)(t + 2) * kstep; const char* b2 = last ? nB : cB + (size_t)(t + 2) * kstep;
            const char* a3 = a2 + kstep; const char* b3 = b2 + kstep;
            PG8_LDB(B0, 0, 0); PG8_LDB(B1, 0, 1); PG8_SCHED; PG8_LDA(At, 0, 0); PG8_STAGE(PG8_SA(1, 1), a1 + hstep, voffA);
            PG8_WAIT_V(8); PG8_WAIT_L(0); PG8_BAR; PG8_MMA(0, 0, At, B0); PG8_MMA(0, 1, At, B1); PG8_BAR; PG8_SCHED;
            PG8_LDA(At, 0, 1); PG8_STAGE(PG8_SB(0, 0), b2, voffB); PG8_STAGE(PG8_SB(0, 1), b2 + hstep, voffB); PG8_STAGE(PG8_SA(0, 0), a2, voffA);
            PG8_WAIT_V(8); PG8_WAIT_L(0); PG8_BAR; PG8_MMA(1, 0, At, B0); PG8_MMA(1, 1, At, B1); PG8_BAR; PG8_SCHED;
            PG8_LDB(B0, 1, 0); PG8_LDB(B1, 1, 1); PG8_SCHED; PG8_LDA(At, 1, 0); PG8_STAGE(PG8_SA(0, 1), a2 + hstep, voffA);
            PG8_WAIT_V(8); PG8_WAIT_L(0); PG8_BAR; PG8_MMA(0, 0, At, B0); PG8_MMA(0, 1, At, B1); PG8_BAR; PG8_SCHED;
            PG8_LDA(At, 1, 1); PG8_STAGE(PG8_SB(1, 0), b3, voffB); PG8_STAGE(PG8_SB(1, 1), b3 + hstep, voffB); PG8_STAGE(PG8_SA(1, 0), a3, voffA);
            PG8_WAIT_V(8); PG8_WAIT_L(0); PG8_BAR; PG8_MMA(1, 0, At, B0); PG8_MMA(1, 1, At, B1); PG8_BAR; PG8_SCHED;
        }
        if (wr == 0) PG8_BAR;
        { int ln = tid; asm volatile("" : "+v"(ln)); E(acc, cur, wr, wc, ln & 15, (ln >> 4) & 3); }
        if (!has_next) break;
#pragma unroll
        for (int a = 0; a < 2; ++a)
#pragma unroll
            for (int b = 0; b < 2; ++b)
#pragma unroll
                for (int m = 0; m < 4; ++m)
#pragma unroll
                    for (int n = 0; n < 2; ++n) acc[a][b][m][n] = (f32x4){0.f, 0.f, 0.f, 0.f};
        cur = nxt; cA = nA; cB = nB; ++ui;
        if (wr == 1) PG8_BAR;
    }
    PG8_WAIT_V(0);
    PG8_BAR;
#undef PG8_SA
#undef PG8_SB
#undef PG8_STAGE
#undef PG8_LDA
#undef PG8_LDB
#undef PG8_MMA
#undef PG8_WAIT_V
#undef PG8_WAIT_L
#undef PG8_BAR
#undef PG8_SCHED
}
}
using pg8::Unit;
typedef f32x4 AccT[2][2][4][2];


#define GPTR(T, base, off) ((T*)((char*)(base) + (unsigned)(off)))
#define GCPTR(T, base, off) ((const T*)((const char*)(base) + (unsigned)(off)))
struct EpiSwiglu {
    static constexpr bool PERM = true;
    bf16_t* H;
    __device__ __forceinline__ void operator()(const AccT& acc, const Unit& u, int wr, int wc, int fr, int fq) const {
        const unsigned o0 = (unsigned)((u.pm * 256 + wr * 64 + fr) * DFF + u.pn * 128 + wc * 32 + 8 * fq) * 2u;
#pragma unroll
        for (int ai = 0; ai < 2; ++ai)
#pragma unroll
            for (int m = 0; m < 4; ++m) {
                float h[8];
#pragma unroll
                for (int n = 0; n < 2; ++n)
#pragma unroll
                    for (int j = 0; j < 4; ++j) { const float a = acc[ai][0][m][n][j], g = acc[ai][1][m][n][j]; h[n * 4 + j] = a * g * sigmoidf_(g); }
                u32x4 w; w.x = cvt_pk_bf16(h[0], h[1]); w.y = cvt_pk_bf16(h[2], h[3]); w.z = cvt_pk_bf16(h[4], h[5]); w.w = cvt_pk_bf16(h[6], h[7]);
                *GPTR(u32x4, H, o0 + (unsigned)((ai * 128 + m * 16) * DFF * 2)) = w;
            }
    }
};
struct EpiResid {
    static constexpr bool PERM = false;
    const float* inL; const float* inC; float* outL; float* outC; const float* gate  ; float fac;
    __device__ __forceinline__ void operator()(const AccT& acc, const Unit& u, int wr, int wc, int fr, int fq) const {
        const int b = u.pm / 9, tt = u.pm - b * 9;
        const float* ib; float* ob; const float* g;
        if (tt == 0) { ib = inC + (size_t)b * 256 * D; ob = outC + (size_t)b * 256 * D; g = gate + 16 * NMOD; }
        else { const size_t o = ((size_t)b * SEQ + (tt - 1) * 256) * D; ib = inL + o; ob = outL + o; g = gate + b * NMOD; }
        const int col0 = u.pn * 256 + wc * 32 + 4 * fq;
        f32x4 gv[2][2];
#pragma unroll
        for (int bj = 0; bj < 2; ++bj)
#pragma unroll
            for (int n = 0; n < 2; ++n) gv[bj][n] = *GCPTR(f32x4, g, (col0 + bj * 128 + n * 16) * 4) * fac;
        const unsigned o0 = (unsigned)((wr * 64 + fr) * D + col0) * 4u;
#pragma unroll
        for (int ai = 0; ai < 2; ++ai) {
            f32x4 xv[4][2][2];
#pragma unroll
            for (int m = 0; m < 4; ++m)
#pragma unroll
                for (int bj = 0; bj < 2; ++bj)
#pragma unroll
                    for (int n = 0; n < 2; ++n) xv[m][bj][n] = *GCPTR(f32x4, ib, o0 + (unsigned)(((ai * 128 + m * 16) * D + bj * 128 + n * 16) * 4));
#pragma unroll
            for (int m = 0; m < 4; ++m)
#pragma unroll
                for (int bj = 0; bj < 2; ++bj)
#pragma unroll
                    for (int n = 0; n < 2; ++n) *GPTR(f32x4, ob, o0 + (unsigned)(((ai * 128 + m * 16) * D + bj * 128 + n * 16) * 4)) = xv[m][bj][n] + gv[bj][n] * acc[ai][bj][m][n];
            asm volatile("" ::: "memory");
        }
    }
};
struct EpiInProj {
    static constexpr bool PERM = false;
    bf16_t *PQT, *PQTC, *VTG, *VTN, *PROJ;
    __device__ __forceinline__ void operator()(const AccT& acc, const Unit& u, int wr, int wc, int fr, int fq) const {
        const int b = u.pm / 9, tt = u.pm - b * 9;
        const int tbase = tt * 256 + wr * 64 + fr;
#pragma unroll
        for (int bj = 0; bj < 2; ++bj) {
            const int hh = 2 * u.pn + bj;
            if (hh >= 7) {
                const float sc = (hh == 12 || hh == 13) ? QSCALE : 1.0f;
                const unsigned o0 = (unsigned)((b * TB + tbase) * PW + (hh - 7) * 128 + wc * 32 + 4 * fq) * 2u;
#pragma unroll
                for (int ai = 0; ai < 2; ++ai)
#pragma unroll
                    for (int m = 0; m < 4; ++m)
#pragma unroll
                        for (int n = 0; n < 2; ++n) { const f32x4 v = acc[ai][bj][m][n] * sc; u32x2 w; w.x = cvt_pk_bf16(v[0], v[1]); w.y = cvt_pk_bf16(v[2], v[3]);
                            *GPTR(u32x2, PROJ, o0 + (unsigned)(((ai * 128 + m * 16) * PW + n * 16) * 2)) = w; }
            } else {
                bf16_t* base; int pitch; int t0;
                if (hh < 4) {
                    const int pq = hh >> 1, ch0 = (hh & 1) * 128;
                    if (tt == 0) { base = PQTC + ((size_t)b * 256 + ch0) * 512 + pq * 256; pitch = 512; t0 = tbase; }
                    else { base = PQT + ((size_t)b * 256 + ch0) * 4096 + pq * 2048; pitch = 4096; t0 = tbase - 256; }
                } else { const int frs = fr ^ ((((fr >> 2) ^ (fr >> 3)) & 1) * 12);
                    if (hh == 4) { base = VTG + (size_t)b * 128 * TB; pitch = TB; t0 = tbase - fr + frs; }
                    else { base = VTN + ((size_t)b * 256 + (hh - 5) * 128) * TB; pitch = TB; t0 = tbase - fr + frs; } }
                const unsigned o0 = (unsigned)((wc * 32 + 4 * fq) * pitch + t0) * 2u;
#pragma unroll
                for (int n = 0; n < 2; ++n)
#pragma unroll
                    for (int j = 0; j < 4; ++j) {
                        const unsigned oc = o0 + (unsigned)((n * 16 + j) * pitch) * 2u;
#pragma unroll
                        for (int ai = 0; ai < 2; ++ai)
#pragma unroll
                            for (int m = 0; m < 4; ++m) *GPTR(bf16_t, base, oc + (unsigned)((ai * 128 + m * 16) * 2)) = (bf16_t)(cvt_pk_bf16(acc[ai][bj][m][n][j], 0.f) & 0xffffu);
                    }
            }
        }
    }
};
struct EpiDft {
    static constexpr bool PERM = true;
    bf16_t* YF; int tofs; float scale;
    __device__ __forceinline__ void operator()(const AccT& acc, const Unit& u, int wr, int wc, int fr, int fq) const {
        const unsigned o0 = (unsigned)((u.pn * TB + tofs + u.pm * 256 + wr * 64 + fr) * 256 + wc * 32 + 8 * fq) * 2u;
#pragma unroll
        for (int ai = 0; ai < 2; ++ai)
#pragma unroll
            for (int m = 0; m < 4; ++m)
#pragma unroll
                for (int bj = 0; bj < 2; ++bj) { const f32x4 v0 = acc[ai][bj][m][0] * scale, v1 = acc[ai][bj][m][1] * scale;
                    u32x4 w; w.x = cvt_pk_bf16(v0[0], v0[1]); w.y = cvt_pk_bf16(v0[2], v0[3]); w.z = cvt_pk_bf16(v1[0], v1[1]); w.w = cvt_pk_bf16(v1[2], v1[3]);
                    *GPTR(u32x4, YF, o0 + (unsigned)(((ai * 128 + m * 16) * 256 + bj * 128) * 2)) = w; }
    }
};
struct EpiGates {
    static constexpr bool PERM = true;
    bf16_t* Gt;
    __device__ __forceinline__ void operator()(const AccT& acc, const Unit& u, int wr, int wc, int fr, int fq) const {
        const unsigned o0 = (unsigned)((u.pm * 256 + wr * 64 + fr) * NGATE + u.pn * 256 + wc * 32 + 8 * fq) * 2u;
#pragma unroll
        for (int ai = 0; ai < 2; ++ai)
#pragma unroll
            for (int m = 0; m < 4; ++m)
#pragma unroll
                for (int bj = 0; bj < 2; ++bj) { float s[8];
#pragma unroll
                    for (int n = 0; n < 2; ++n)
#pragma unroll
                        for (int j = 0; j < 4; ++j) s[n * 4 + j] = sigmoidf_(acc[ai][bj][m][n][j]);
                    u32x4 w; w.x = cvt_pk_bf16(s[0], s[1]); w.y = cvt_pk_bf16(s[2], s[3]); w.z = cvt_pk_bf16(s[4], s[5]); w.w = cvt_pk_bf16(s[6], s[7]);
                    *GPTR(u32x4, Gt, o0 + (unsigned)(((ai * 128 + m * 16) * NGATE + bj * 128) * 2)) = w; }
    }
};
template <bool FIRST> struct EpiMerge {
    static constexpr bool PERM = true;
    const bf16_t* Gt  ; bf16_t* Mg;
    __device__ __forceinline__ void operator()(const AccT& acc, const Unit& u, int wr, int wc, int fr, int fq) const {
        const int row0 = u.pm * 256 + wr * 64 + fr, col0 = u.pn * 256 + wc * 32 + 8 * fq;
        const unsigned og0 = (unsigned)(row0 * NGATE + col0) * 2u, om0 = (unsigned)(row0 * D + col0) * 2u;
#pragma unroll
        for (int ai = 0; ai < 2; ++ai) {
            u32x4 gwv[4][2], owv[4][2];
#pragma unroll
            for (int m = 0; m < 4; ++m)
#pragma unroll
                for (int bj = 0; bj < 2; ++bj) {
                    gwv[m][bj] = *GCPTR(u32x4, Gt, og0 + (unsigned)(((ai * 128 + m * 16) * NGATE + bj * 128) * 2));
                    if (!FIRST) owv[m][bj] = *GCPTR(u32x4, Mg, om0 + (unsigned)(((ai * 128 + m * 16) * D + bj * 128) * 2));
                    else owv[m][bj] = (u32x4){0u, 0u, 0u, 0u};
                }
#pragma unroll
            for (int m = 0; m < 4; ++m)
#pragma unroll
                for (int bj = 0; bj < 2; ++bj) {
                    const u32x4 gw = gwv[m][bj], ow = owv[m][bj];
                    const f32x4 a0 = acc[ai][bj][m][0], a1 = acc[ai][bj][m][1];
                    float o[8];
                    o[0] = bflo(ow.x) + bflo(gw.x) * a0[0]; o[1] = bfhi(ow.x) + bfhi(gw.x) * a0[1];
                    o[2] = bflo(ow.y) + bflo(gw.y) * a0[2]; o[3] = bfhi(ow.y) + bfhi(gw.y) * a0[3];
                    o[4] = bflo(ow.z) + bflo(gw.z) * a1[0]; o[5] = bfhi(ow.z) + bfhi(gw.z) * a1[1];
                    o[6] = bflo(ow.w) + bflo(gw.w) * a1[2]; o[7] = bfhi(ow.w) + bfhi(gw.w) * a1[3];
                    u32x4 w; w.x = cvt_pk_bf16(o[0], o[1]); w.y = cvt_pk_bf16(o[2], o[3]); w.z = cvt_pk_bf16(o[4], o[5]); w.w = cvt_pk_bf16(o[6], o[7]);
                    *GPTR(u32x4, Mg, om0 + (unsigned)(((ai * 128 + m * 16) * D + bj * 128) * 2)) = w;
                }
            asm volatile("" ::: "memory");
        }
    }
};

#define MFMA32(a, b, c) __builtin_amdgcn_mfma_f32_32x32x16_bf16((a), (b), (c), 0, 0, 0)
template <int NS, bool MASK>
__device__ __forceinline__ void attn_unit(LAS unsigned char* lds, const bf16_t* proj, int b, int t0, int qcol0, int kcol0, const bf16_t* vt0, int l0, int l1,
                                          bf16_t* Y, int ldy, int ycol0, const float* rpb, int qrow, const int wid) {
    const int tid = opaque_tid(wid), lane = tid & 63, r32 = lane & 31, hi = lane >> 5;
    const int g = wid >> 1, half = wid & 1, slot = (NS == 1) ? 0 : g;
    const size_t rowb = (size_t)b * TB;
    bf16x8 qr[4];
    { const bf16_t* qp = proj + (rowb + t0 + 32 * half + r32) * PW + qcol0 + g * 64 + 8 * hi;
#pragma unroll
      for (int d0 = 0; d0 < 4; ++d0) qr[d0] = *(const bf16x8*)(qp + 16 * d0); }
    const int lrow = tid >> 3, lch = tid & 7;
    const bf16_t* ksrc = proj + (rowb + lrow) * PW + kcol0 + lch * 8;
    const bf16_t* vsrc = vt0 + (size_t)lrow * TB + lch * 8;
    const unsigned ldst = (unsigned)(lrow * 128 + ((lch ^ ((lrow >> 1) & 7)) << 4));
    const unsigned vdst0 = (unsigned)(lrow * 128 + ((((lch & 6) + 0) ^ ((lrow >> 1) & 7)) << 4) + 8 * (lch & 1));
    const unsigned vdst1 = (unsigned)(lrow * 128 + ((((lch & 6) + 1) ^ ((lrow >> 1) & 7)) << 4) + 8 * (lch & 1));
    u32x4 kreg[NS], vreg[NS];
    const int ntile = 4 + (l1 - l0);
#define ATT_LOAD(it) do { const int kt_ = (it) < 4 ? (it) : l0 + (it) - 4; _Pragma("unroll") for (int s_ = 0; s_ < NS; ++s_) { \
        kreg[s_] = *(const u32x4*)(ksrc + (size_t)kt_ * 64 * PW + s_ * 64); vreg[s_] = *(const u32x4*)(vsrc + kt_ * 64 + (size_t)s_ * 64 * TB); } } while (0)
    constexpr int STG = NS * 16384;
#define ATT_STORE(st) do { _Pragma("unroll") for (int s_ = 0; s_ < NS; ++s_) { *(LAS u32x4*)(lds + (st) * STG + s_ * 16384 + ldst) = kreg[s_]; *(LAS u32x4*)(lds + (st) * STG + s_ * 16384 + 8192 + ldst) = vreg[s_]; } } while (0)
    const LAS unsigned char* kb0 = lds + slot * 16384 + r32 * 128;
    const LAS unsigned char* vb0 = lds + slot * 16384 + 8192 + r32 * 128;
    const int sw = (r32 >> 1) & 7;
    f32x16 o0, o1;
#pragma unroll
    for (int i = 0; i < 16; ++i) { o0[i] = 0.f; o1[i] = 0.f; }
    float mrun = -INFINITY, lsum = 0.f;
    const int qc = 32 * half + r32;
    const int cs = min(max(qc - 8, 0), 48);
    ATT_LOAD(0);
    __syncthreads();
    ATT_STORE(0);
    __syncthreads();
    for (int it = 0; it < ntile; ++it) {
        if (it + 1 < ntile) ATT_LOAD(it + 1);
        const LAS unsigned char* kb = kb0 + (it & 1) * STG;
        const LAS unsigned char* vb = vb0 + (it & 1) * STG;
        f32x16 p0, p1;
#pragma unroll
        for (int i = 0; i < 16; ++i) { p0[i] = 0.f; p1[i] = 0.f; }
#pragma unroll
        for (int d0 = 0; d0 < 4; ++d0) {
            const int co = ((2 * d0 + hi) ^ sw) << 4;
            const bf16x8 k0 = *(const LAS bf16x8*)(kb + co), k1 = *(const LAS bf16x8*)(kb + 4096 + co);
            p0 = MFMA32(k0, qr[d0], p0); p1 = MFMA32(k1, qr[d0], p1);
        }
        if (MASK && it >= 4) {
            const int dr = (l0 + it - 8) - qrow + 7;
            const LAS float* bp = (const LAS float*)(lds + LDS_RPB) + (g * 15 + dr) * 32;
#pragma unroll
            for (int r = 0; r < 16; ++r) {
                const int kc0 = (r & 3) + 8 * (r >> 2) + 4 * hi, kc1 = kc0 + 32;
                const int i0 = min(max(kc0 - qc + 15, 0), 30), i1 = min(max(kc1 - qc + 15, 0), 30);
                const float b0 = bp[i0], b1 = bp[i1];
                p0[r] = (kc0 >= cs && kc0 < cs + 16) ? p0[r] + b0 : -INFINITY;
                p1[r] = (kc1 >= cs && kc1 < cs + 16) ? p1[r] + b1 : -INFINITY;
            }
        }
        float mx = fmaxf(p0[0], p1[0]);
#pragma unroll
        for (int r = 1; r < 16; ++r) mx = fmaxf(mx, fmaxf(p0[r], p1[r]));
        mx = fmaxf(mx, shx(mx, 32, lane));
        const float mnew = fmaxf(mrun, mx);
        const float alpha = fexp2(mrun - mnew);
        mrun = mnew;
        float ps = 0.f;
#pragma unroll
        for (int r = 0; r < 16; ++r) { p0[r] = fexp2(p0[r] - mnew); p1[r] = fexp2(p1[r] - mnew); ps += p0[r] + p1[r]; }
        lsum = lsum * alpha + ps;
#pragma unroll
        for (int i = 0; i < 16; ++i) { o0[i] *= alpha; o1[i] *= alpha; }
        bf16x8 pb[4];
#pragma unroll
        for (int s = 0; s < 2; ++s) {
            u32x4 w0, w1;
            w0.x = cvt_pk_bf16(p0[8 * s + 0], p0[8 * s + 1]); w0.y = cvt_pk_bf16(p0[8 * s + 2], p0[8 * s + 3]); w0.z = cvt_pk_bf16(p0[8 * s + 4], p0[8 * s + 5]); w0.w = cvt_pk_bf16(p0[8 * s + 6], p0[8 * s + 7]);
            w1.x = cvt_pk_bf16(p1[8 * s + 0], p1[8 * s + 1]); w1.y = cvt_pk_bf16(p1[8 * s + 2], p1[8 * s + 3]); w1.z = cvt_pk_bf16(p1[8 * s + 4], p1[8 * s + 5]); w1.w = cvt_pk_bf16(p1[8 * s + 6], p1[8 * s + 7]);
            pb[s] = __builtin_bit_cast(bf16x8, w0); pb[2 + s] = __builtin_bit_cast(bf16x8, w1);
        }
#pragma unroll
        for (int ks = 0; ks < 4; ++ks) {
            const int c0 = ((2 * ks + hi) ^ sw) << 4;
            const bf16x8 va = *(const LAS bf16x8*)(vb + c0), ve = *(const LAS bf16x8*)(vb + 4096 + c0);
            o0 = MFMA32(va, pb[ks], o0);
            o1 = MFMA32(ve, pb[ks], o1);
        }
        if (it + 1 < ntile) ATT_STORE((it + 1) & 1);
        __syncthreads();
    }
    lsum += shx(lsum, 32, lane);
    const float inv = 1.0f / lsum;
    bf16_t* yp = Y + (rowb + t0 + 32 * half + r32) * ldy + ycol0 + g * 64 + 4 * hi;
#pragma unroll
    for (int rg = 0; rg < 4; ++rg) {
        u32x2 w; w.x = cvt_pk_bf16(o0[4 * rg] * inv, o0[4 * rg + 1] * inv); w.y = cvt_pk_bf16(o0[4 * rg + 2] * inv, o0[4 * rg + 3] * inv);
        *(u32x2*)(yp + 8 * rg) = w;
        u32x2 x; x.x = cvt_pk_bf16(o1[4 * rg] * inv, o1[4 * rg + 1] * inv); x.y = cvt_pk_bf16(o1[4 * rg + 2] * inv, o1[4 * rg + 3] * inv);
        *(u32x2*)(yp + 32 + 8 * rg) = x;
    }
#undef ATT_LOAD
#undef ATT_STORE
}

#ifndef DBG
#define DBG 0
#endif
struct Args { const float* in[22]; float* out; unsigned char* ws; int dbg; int pad; };
typedef const __attribute__((address_space(4))) Args* KArgs;
__device__ __forceinline__ KArgs kargs() { KArgs p = (KArgs)__builtin_amdgcn_kernarg_segment_ptr(); asm volatile("" : "+s"(p)); return p; }

__device__ __forceinline__ void cvt_item(const float* W, int ldw, int srccol0, bf16_t* WT, int K, int k0, LAS float* scr, int lane) {
#pragma unroll
    for (int i = 0; i < 32; ++i) { const int kk = 2 * i + (lane >> 5); scr[kk * 33 + (lane & 31)] = W[(size_t)(k0 + kk) * ldw + srccol0 + (lane & 31)]; }
    LDS_WAIT();
    const int c = lane & 7;
#pragma unroll
    for (int j = 0; j < 4; ++j) { const int n = (lane >> 3) + 8 * j; const LAS float* s = scr + (8 * c) * 33 + n;
        u32x4 o; o.x = cvt_pk_bf16(s[0 * 33], s[1 * 33]); o.y = cvt_pk_bf16(s[2 * 33], s[3 * 33]); o.z = cvt_pk_bf16(s[4 * 33], s[5 * 33]); o.w = cvt_pk_bf16(s[6 * 33], s[7 * 33]);
        *(u32x4*)(WT + (size_t)n * K + k0 + 8 * c) = o; }
    LDS_WAIT();
}
__device__ __forceinline__ float cos_rev(float x) { return __builtin_amdgcn_cosf(x); }
__device__ __forceinline__ float sin_rev(float x) { return __builtin_amdgcn_sinf(x); }

__device__ __forceinline__ void convert_weights(int l, LAS unsigned char* lds, const int wid, int b0 = 0, int nb = 0, int cmode = 0) {
    KArgs a = kargs();
    if (nb == 0) nb = gridDim.x;
    const int tid_ = opaque_tid(wid), lane = tid_ & 63, gw = ((int)blockIdx.x - b0) * 8 + wid, NGW = nb * 8;
    unsigned char* ws = a->ws;
    LAS float* scr = (LAS float*)(lds + wid * 16384);
    const float* f1i = a->in[7] + (size_t)l * D * 2 * DFF; const float* f1o = a->in[8] + (size_t)l * DFF * D;
    const float* f2i = a->in[19] + (size_t)l * D * 2 * DFF; const float* f2o = a->in[20] + (size_t)l * DFF * D;
    const float* win = a->in[10] + (size_t)l * D * INW;
    const float* wf = a->in[14] + (size_t)l * 256 * D; const float* wg = a->in[15] + (size_t)l * 512 * D; const float* wn = a->in[16] + (size_t)l * 256 * D; const float* wo = a->in[17] + (size_t)l * D * D;
    constexpr int I_FI = 16 * 176, I_FO = 44 * 32, I_IP = 16 * 48, I_GT = 16 * 96, I_WF = 4 * 32, I_WG = 8 * 32, I_WN = 4 * 32, I_WO = 16 * 32, I_PQ = 32 * 8;
    constexpr int NIT = 2 * I_FI + 2 * I_FO + I_IP + I_GT + I_WF + I_WG + I_WN + I_WO + I_PQ;
    for (int it = gw; it < NIT; it += NGW) {
        int r = it;
        { const bool f2o = (it >= 2 * I_FI + I_FO) && (it < 2 * I_FI + 2 * I_FO); if ((cmode == 1 && f2o) || (cmode == 2 && !f2o)) continue; }
        if (r < 2 * I_FI) { const int which = r / I_FI; r -= which * I_FI; const int kb = r / 176, db = r % 176, p = db >> 3, w8 = db & 7;
            cvt_item(which ? f2i : f1i, 2 * DFF, (w8 >> 2) * DFF + 128 * p + 32 * (w8 & 3), (bf16_t*)(ws + (which ? W_FFN2_IN : W_FFN1_IN)) + (size_t)32 * db * D, D, 64 * kb, scr, lane); continue; }
        r -= 2 * I_FI;
        if (r < 2 * I_FO) { const int which = r / I_FO; r -= which * I_FO; const int kb = r / 32, db = r % 32;
            cvt_item(which ? f2o : f1o, D, 32 * db, (bf16_t*)(ws + (which ? W_FFN2_OUT : W_FFN1_OUT)) + (size_t)32 * db * DFF, DFF, 64 * kb, scr, lane); continue; }
        r -= 2 * I_FO;
        if (r < I_IP) { const int kb = r / 48, row0 = 512 + 32 * (r % 48); int sc;
            if (row0 < 640) sc = 896 + (row0 - 512); else if (row0 < 896) sc = 1536 + (row0 - 640); else if (row0 < 1024) sc = 768 + (row0 - 896);
            else if (row0 < 1536) sc = 256 + (row0 - 1024); else if (row0 < 1792) sc = 1024 + (row0 - 1536); else sc = 1280 + (row0 - 1792);
            cvt_item(win, INW, sc, (bf16_t*)(ws + W_INP) + (size_t)row0 * D, D, 64 * kb, scr, lane); continue; }
        r -= I_IP;
        if (r < I_GT) { const int kb = r / 96, db = r % 96; cvt_item(win, INW, 1792 + 32 * db, (bf16_t*)(ws + W_GATE) + (size_t)32 * db * D, D, 64 * kb, scr, lane); continue; }
        r -= I_GT;
        if (r < I_WF) { const int kb = r / 32, db = r % 32; cvt_item(wf, D, 32 * db, (bf16_t*)(ws + W_FOUR) + (size_t)32 * db * 256, 256, 64 * kb, scr, lane); continue; }
        r -= I_WF;
        if (r < I_WG) { const int kb = r / 32, db = r % 32; cvt_item(wg, D, 32 * db, (bf16_t*)(ws + W_GQAO) + (size_t)32 * db * 512, 512, 64 * kb, scr, lane); continue; }
        r -= I_WG;
        if (r < I_WN) { const int kb = r / 32, db = r % 32; cvt_item(wn, D, 32 * db, (bf16_t*)(ws + W_NAO) + (size_t)32 * db * 256, 256, 64 * kb, scr, lane); continue; }
        r -= I_WN;
        if (r < I_WO) { const int kb = r / 32, db = r % 32; cvt_item(wo, D, 32 * db, (bf16_t*)(ws + W_O) + (size_t)32 * db * D, D, 64 * kb, scr, lane); continue; }
        r -= I_WO;
        {
            const int kb = r >> 3, combo = r & 7, pq = combo >> 2, gq = combo & 3, k0 = 32 * kb;
#pragma unroll
            for (int i = 0; i < 32; ++i) scr[i * 65 + lane] = win[(size_t)(k0 + i) * INW + gq * 64 + lane];
            LDS_WAIT();
            float accv[32];
#pragma unroll
            for (int i = 0; i < 32; ++i) accv[i] = 0.f;
            for (int c = 0; c < 64; ++c) {
                const float ph = (float)((lane * c) & 63) * (1.0f / 64.0f);
                const float tv = pq ? sin_rev(ph) : cos_rev(ph);
#pragma unroll
                for (int i = 0; i < 32; ++i) accv[i] += scr[i * 65 + c] * tv;
            }
            bf16_t* dst = (bf16_t*)(ws + W_INP) + (size_t)(pq * 256 + gq * 64 + lane) * D + k0;
#pragma unroll
            for (int q4 = 0; q4 < 4; ++q4) { u32x4 o; o.x = cvt_pk_bf16(accv[8 * q4], accv[8 * q4 + 1]); o.y = cvt_pk_bf16(accv[8 * q4 + 2], accv[8 * q4 + 3]);
                o.z = cvt_pk_bf16(accv[8 * q4 + 4], accv[8 * q4 + 5]); o.w = cvt_pk_bf16(accv[8 * q4 + 6], accv[8 * q4 + 7]); *(u32x4*)(dst + 8 * q4) = o; }
            LDS_WAIT();
        }
    }
}

__device__ __forceinline__ void dft_tables(const int wid) {
    KArgs a = kargs(); unsigned char* ws = a->ws;
    bf16_t* DFT = (bf16_t*)(ws + WS_DFT); bf16_t* DFTC = (bf16_t*)(ws + WS_DFTC);
    const int gt = blockIdx.x * 512 + opaque_tid(wid), NT = gridDim.x * 512;
    for (int i = gt; i < 2048 * 512; i += NT) {
        const int k1 = i >> 9, c8 = (i & 511) * 8, pq = c8 >> 11, t0 = c8 & 2047; float v[8];
#pragma unroll
        for (int j = 0; j < 8; ++j) { const float ph = (float)((k1 * (t0 + j)) & 2047) * (1.0f / 2048.0f); v[j] = pq ? -sin_rev(ph) : cos_rev(ph); }
        u32x4 o; o.x = cvt_pk_bf16(v[0], v[1]); o.y = cvt_pk_bf16(v[2], v[3]); o.z = cvt_pk_bf16(v[4], v[5]); o.w = cvt_pk_bf16(v[6], v[7]);
        *(u32x4*)(DFT + (size_t)k1 * 4096 + c8) = o;
    }
    for (int i = gt; i < 256 * 64; i += NT) {
        const int k1 = i >> 6, c8 = (i & 63) * 8, pq = c8 >> 8, t0 = c8 & 255; float v[8];
#pragma unroll
        for (int j = 0; j < 8; ++j) { const float ph = (float)((k1 * (t0 + j)) & 255) * (1.0f / 256.0f); v[j] = pq ? -sin_rev(ph) : cos_rev(ph); }
        u32x4 o; o.x = cvt_pk_bf16(v[0], v[1]); o.y = cvt_pk_bf16(v[2], v[3]); o.z = cvt_pk_bf16(v[4], v[5]); o.w = cvt_pk_bf16(v[6], v[7]);
        *(u32x4*)(DFTC + (size_t)k1 * 512 + c8) = o;
    }
}

__device__ __forceinline__ void mod_vectors(LAS unsigned char* lds, const int wid) {
    KArgs a = kargs(); float* mod = (float*)(a->ws + WS_MOD);
    const int tid = opaque_tid(wid), lane = tid & 63;
    const float* cin = a->in[1]; const float* cctx = a->in[3]; const float* modw = a->in[4]; const float* modb = a->in[5];
    LAS float* S = (LAS float*)lds;
    LAS float* red = (LAS float*)(lds + 69632);
    for (int i = tid; i < 17 * 1024; i += 512) { const float cvv = i < 16 * 1024 ? cin[i] : cctx[i - 16 * 1024]; S[i] = cvv * sigmoidf_(cvv); }
    __syncthreads();
    for (int unit = blockIdx.x; unit < 288; unit += gridDim.x) {
        const int l = unit / 144, n0 = (unit % 144) * 64;
        const float* wp = modw + (size_t)l * D * NMOD + n0 + lane;
        float accm[17];
#pragma unroll
        for (int m = 0; m < 17; ++m) accm[m] = 0.f;
        const int kbeg = wid * 128;
#pragma unroll 8
        for (int k = kbeg; k < kbeg + 128; ++k) {
            const float wv = wp[(size_t)k * NMOD];
#pragma unroll
            for (int m = 0; m < 17; ++m) accm[m] += S[m * 1024 + k] * wv;
        }
#pragma unroll
        for (int m = 0; m < 17; ++m) red[(wid * 17 + m) * 64 + lane] = accm[m];
        __syncthreads();
        for (int i = tid; i < 17 * 64; i += 512) {
            const int m = i >> 6, c = i & 63; float s = modb[(size_t)l * NMOD + n0 + c];
#pragma unroll
            for (int w = 0; w < 8; ++w) s += red[(w * 17 + m) * 64 + c];
            mod[((size_t)l * 17 + m) * NMOD + n0 + c] = s;
        }
        __syncthreads();
    }
}

__device__ __forceinline__ void norm_rows(int l, int which, bool first, int mode, const int wid, int b0 = 0, int nb = 0) {
    KArgs a = kargs(); unsigned char* ws = a->ws;
    if (nb == 0) nb = gridDim.x;
    const int tid_ = opaque_tid(wid), lane = tid_ & 63, gw = ((int)blockIdx.x - b0) * 8 + wid, NGW = nb * 8;
    const float* inL = first ? a->in[0] : a->out; const float* inC = first ? a->in[2] : (const float*)(ws + WS_XC);
    const float* gain = a->in[which == 0 ? 6 : (which == 1 ? 9 : 18)] + l * D;
    const float* modl = (const float*)(ws + WS_MOD) + (size_t)l * 17 * NMOD; const int sidx = 3 * which;
    bf16_t* U = (bf16_t*)(ws + WS_U);
    f32x4 gn[4];
#pragma unroll
    for (int j = 0; j < 4; ++j) gn[j] = *(const f32x4*)(gain + 4 * lane + 256 * j);
    const int nrows = mode == 1 ? NBATCH * SEQ : (mode == 2 ? NBATCH * CTX : MT);
    for (int r0 = gw; r0 < nrows; r0 += 2 * NGW) {
        const float* src[2]; const float* sh[2]; int rr[2]; bool ok[2];
        f32x4 v[2][4];
#pragma unroll
        for (int q = 0; q < 2; ++q) {
            const int rq = r0 + q * NGW; ok[q] = rq < nrows; const int rc = ok[q] ? rq : r0;
            const int r = mode == 1 ? (rc >> 11) * TB + CTX + (rc & 2047) : (mode == 2 ? (rc >> 8) * TB + (rc & 255) : rc);
            const int b = r / TB, t = r - b * TB; rr[q] = r;
            src[q] = t < CTX ? inC + ((size_t)b * CTX + t) * D : inL + ((size_t)b * SEQ + t - CTX) * D;
            sh[q] = modl + (size_t)(t < CTX ? 16 : b) * NMOD + sidx * D;
#pragma unroll
            for (int j = 0; j < 4; ++j) v[q][j] = *(const f32x4*)(src[q] + 4 * lane + 256 * j);
        }
#pragma unroll
        for (int q = 0; q < 2; ++q) {
            float ss = 0.f;
#pragma unroll
            for (int j = 0; j < 4; ++j) ss += (v[q][j].x * v[q][j].x + v[q][j].y * v[q][j].y) + (v[q][j].z * v[q][j].z + v[q][j].w * v[q][j].w);
            const float rstd = 1.0f / sqrtf(wave_sum(ss, lane) * (1.0f / D) + EPS);
            if (ok[q]) {
                bf16_t* dst = U + (size_t)rr[q] * D; const float* sc = sh[q] + D;
#pragma unroll
                for (int j = 0; j < 4; ++j) {
                    const f32x4 s1 = *(const f32x4*)(sc + 4 * lane + 256 * j), s0 = *(const f32x4*)(sh[q] + 4 * lane + 256 * j);
                    const f32x4 y = (v[q][j] * rstd * gn[j]) * (s1 + 1.0f) + s0;
                    u32x2 w; w.x = cvt_pk_bf16(y.x, y.y); w.y = cvt_pk_bf16(y.z, y.w);
                    *(u32x2*)(dst + 4 * lane + 256 * j) = w;
                }
            }
        }
    }
}

__device__ __forceinline__ void qk_post(int l, const int wid) {
    KArgs a = kargs(); bf16_t* PROJ = (bf16_t*)(a->ws + WS_BIG);
    const int tid_ = opaque_tid(wid), lane = tid_ & 63, gw = blockIdx.x * 8 + wid, NGW = gridDim.x * 8;
    const int sub = lane >> 5, i = lane & 31;
    const float* qn = a->in[11] + l * 64; const float* kn = a->in[12] + l * 64;
    const float gq0 = qn[2 * i], gq1 = qn[2 * i + 1], gk0 = kn[2 * i], gk1 = kn[2 * i + 1];
    const float freq = fexp2(-(float)(i & 15) * (13.287712379549449f / 16.0f)) * 0.15915494309189535f;
    for (int r0 = gw; r0 < MT; r0 += 4 * NGW) {
        unsigned wv[4][5];
#pragma unroll
        for (int q = 0; q < 4; ++q) { const int rq = r0 + q * NGW; const int rc = rq < MT ? rq : r0; const unsigned* rowp = (const unsigned*)(PROJ + (size_t)rc * PW);
#pragma unroll
            for (int itx = 0; itx < 5; ++itx) wv[q][itx] = rowp[(2 * itx + sub) * 32 + i]; }
#pragma unroll
        for (int q = 0; q < 4; ++q) {
            const int r = r0 + q * NGW;
            if (r < MT) {
                const int b = r / TB, t = r - b * TB;
                float cs_ = 1.f, sn_ = 0.f;
                if (t >= CTX) { const int pos = t - CTX; const float p = (float)(i < 16 ? (pos >> 6) : (pos & 63)); const float rev = p * freq; const float fr_ = rev - floorf(rev); cs_ = cos_rev(fr_); sn_ = sin_rev(fr_); }
                unsigned* rowp = (unsigned*)(PROJ + (size_t)r * PW);
#pragma unroll
                for (int itx = 0; itx < 5; ++itx) {
                    const int hd = 2 * itx + sub;
                    const unsigned w = wv[q][itx]; const float x0 = bflo(w), x1 = bfhi(w);
                    float ss = x0 * x0 + x1 * x1;
#pragma unroll
                    for (int o = 1; o < 32; o <<= 1) ss += shx(ss, o, lane);
                    const float rstd = 1.0f / sqrtf(ss * (1.0f / 64.0f) + EPS);
                    const bool isk = hd < 2;
                    const float y0 = x0 * rstd * (isk ? gk0 : gq0), y1 = x1 * rstd * (isk ? gk1 : gq1);
                    const float sc = isk ? 1.0f : QSCALE;
                    rowp[hd * 32 + i] = cvt_pk_bf16((y0 * cs_ - y1 * sn_) * sc, (y0 * sn_ + y1 * cs_) * sc);
                }
            }
        }
    }
}

__device__ __forceinline__ void final_norm(const int wid) {
    KArgs a = kargs(); float* XL = a->out; const float* gain = a->in[21];
    const int tid_ = opaque_tid(wid), lane = tid_ & 63, gw = blockIdx.x * 8 + wid, NGW = gridDim.x * 8;
    f32x4 gn[4];
#pragma unroll
    for (int j = 0; j < 4; ++j) gn[j] = *(const f32x4*)(gain + 4 * lane + 256 * j);
    for (int r = gw; r < NBATCH * SEQ; r += 2 * NGW) {
        float* row0 = XL + (size_t)r * D; const bool ok1 = r + NGW < NBATCH * SEQ; float* row1 = XL + (size_t)(ok1 ? r + NGW : r) * D;
        f32x4 v[4], u[4]; float ss = 0.f, su = 0.f;
#pragma unroll
        for (int j = 0; j < 4; ++j) { v[j] = *(const f32x4*)(row0 + 4 * lane + 256 * j); u[j] = *(const f32x4*)(row1 + 4 * lane + 256 * j); }
#pragma unroll
        for (int j = 0; j < 4; ++j) { ss += (v[j].x * v[j].x + v[j].y * v[j].y) + (v[j].z * v[j].z + v[j].w * v[j].w); su += (u[j].x * u[j].x + u[j].y * u[j].y) + (u[j].z * u[j].z + u[j].w * u[j].w); }
        const float rstd = 1.0f / sqrtf(wave_sum(ss, lane) * (1.0f / D) + EPS), rstu = 1.0f / sqrtf(wave_sum(su, lane) * (1.0f / D) + EPS);
#pragma unroll
        for (int j = 0; j < 4; ++j) *(f32x4*)(row0 + 4 * lane + 256 * j) = v[j] * rstd * gn[j];
        if (ok1) {
#pragma unroll
            for (int j = 0; j < 4; ++j) *(f32x4*)(row1 + 4 * lane + 256 * j) = u[j] * rstu * gn[j];
        }
    }
}

__device__ __forceinline__ void ph_ffn_in(int which, int lat, LAS unsigned char* lds, const int wid) {
    KArgs a = kargs(); unsigned char* ws = a->ws;
    pg8::Gemm g{(const bf16_t*)(ws + WS_U), (const bf16_t*)(ws + (which ? W_FFN2_IN : W_FFN1_IN)), MT, 2 * DFF, D}; pg8::StaticOrder S; S.init(MT, 2 * DFF, gridDim.x, blockIdx.x, lat);
    EpiSwiglu E{(bf16_t*)(ws + WS_BIG)};
    pg8::gemm_phase(lds, g, S, E, wid);
}
__device__ __forceinline__ void ph_resid(int l, int which  , bool first, int mode, LAS unsigned char* lds, const int wid) {
    KArgs a = kargs(); unsigned char* ws = a->ws;
    const bf16_t* A = (const bf16_t*)(ws + (which == 1 ? WS_U : WS_BIG));
    const bf16_t* Bt = (const bf16_t*)(ws + (which == 0 ? W_FFN1_OUT : (which == 1 ? W_O : W_FFN2_OUT)));
    pg8::Gemm g{A, Bt, MT, D, which == 1 ? D : DFF};
    float* XL = a->out; float* XC = (float*)(ws + WS_XC);
    const float* modl = (const float*)(ws + WS_MOD) + (size_t)l * 17 * NMOD;
    EpiResid E{first ? a->in[0] : XL, first ? a->in[2] : XC, XL, XC, modl + (which == 0 ? 2 : (which == 1 ? 5 : 8)) * D, which == 1 ? 1.0f : 0.5f};
    if (mode == 2) { pg8::OneUnit S{9 * ((int)blockIdx.x >> 2), (int)blockIdx.x & 3}; pg8::gemm_phase(lds, g, S, E, wid); }
    else { pg8::StaticOrder S; S.init(MT, D, gridDim.x, blockIdx.x, mode); pg8::gemm_phase(lds, g, S, E, wid); }
}
__device__ __forceinline__ void ph_inproj(LAS unsigned char* lds, const int wid) {
    KArgs a = kargs(); unsigned char* ws = a->ws;
    pg8::Gemm g{(const bf16_t*)(ws + WS_U), (const bf16_t*)(ws + W_INP), MT, NPROJ, D}; pg8::StaticOrder S; S.init(MT, NPROJ, gridDim.x, blockIdx.x);
    EpiInProj E{(bf16_t*)(ws + WS_PQT), (bf16_t*)(ws + WS_PQTC), (bf16_t*)(ws + WS_VTG), (bf16_t*)(ws + WS_VTN), (bf16_t*)(ws + WS_BIG)};
    pg8::gemm_phase(lds, g, S, E, wid);
}
__device__ __forceinline__ void ph_gates(int lat, LAS unsigned char* lds, const int wid) {
    KArgs a = kargs(); unsigned char* ws = a->ws;
    pg8::Gemm g{(const bf16_t*)(ws + WS_U), (const bf16_t*)(ws + W_GATE), MT, NGATE, D}; pg8::StaticOrder S; S.init(MT, NGATE, gridDim.x, blockIdx.x, lat);
    EpiGates E{(bf16_t*)(ws + WS_BIG)};
    pg8::gemm_phase(lds, g, S, E, wid);
}
template <int BR> __device__ __forceinline__ void ph_merge(int lat, LAS unsigned char* lds, const int wid) {
    KArgs a = kargs(); unsigned char* ws = a->ws;
    pg8::StaticOrder S; S.init(MT, D, gridDim.x, blockIdx.x, lat);
    const bf16_t* A = (const bf16_t*)(ws + (BR == 0 ? WS_YF : (BR == 1 ? WS_YG : WS_YN)));
    const bf16_t* Bt = (const bf16_t*)(ws + (BR == 0 ? W_FOUR : (BR == 1 ? W_GQAO : W_NAO)));
    pg8::Gemm g{A, Bt, MT, D, BR == 1 ? 512 : 256};
    EpiMerge<BR == 0> E{(const bf16_t*)(ws + WS_BIG) + BR * D, (bf16_t*)(ws + WS_U)};
    pg8::gemm_phase(lds, g, S, E, wid);
}
__device__ __forceinline__ void ph_dft(int item, bool ctx, LAS unsigned char* lds, const int wid) {
    KArgs a = kargs(); unsigned char* ws = a->ws;
    if (!ctx) { pg8::Gemm g{(const bf16_t*)(ws + WS_DFT), (const bf16_t*)(ws + WS_PQT), 2048, 4096, 4096}; pg8::OneUnit S{item & 7, item >> 3}; EpiDft E{(bf16_t*)(ws + WS_YF), CTX, 1.0f / 362.03867196751236f};
        pg8::gemm_phase(lds, g, S, E, wid); }
    else { pg8::Gemm g{(const bf16_t*)(ws + WS_DFTC), (const bf16_t*)(ws + WS_PQTC), 256, 4096, 512}; pg8::OneUnit S{0, item}; EpiDft E{(bf16_t*)(ws + WS_YF), 0, 1.0f / 128.0f};
        pg8::gemm_phase(lds, g, S, E, wid); }
}
__device__ __forceinline__ void ph_mixers(int l, LAS unsigned char* lds, const int wid) {
    const int n_dft = 128, n_gl = 1024, n_nl = 512, n_dc = (l == 0) ? 16 : 0, n_gc = (l == 0) ? 128 : 0, n_nc = (l == 0) ? 64 : 0;
    const int total = n_dft + n_gl + n_nl + n_dc + n_gc + n_nc;
    LAS int* qslot = (LAS int*)(lds + LDS_RING);
    { const float* rp = kargs()->in[13] + (size_t)l * 4 * 465; LAS float* T = (LAS float*)(lds + LDS_RPB);
      for (int i = opaque_tid(wid); i < 4 * 15 * 32; i += 512) { const int c = i & 31, hr = i >> 5; T[i] = c < 31 ? rp[hr * 31 + c] * LOG2E : 0.f; }
      __syncthreads(); }
    for (;;) {
        KArgs a = kargs(); unsigned char* ws = a->ws;
        if (opaque_tid(wid) == 0) *qslot = (int)atomicAdd((unsigned*)(ws + WS_CTL) + 64 * l, 1u);
        __syncthreads();
        int item = __builtin_amdgcn_readfirstlane(*qslot);
        __syncthreads();
        if (item >= total) break;
        const bf16_t* PROJ = (const bf16_t*)(ws + WS_BIG); const bf16_t* VTG = (const bf16_t*)(ws + WS_VTG); const bf16_t* VTN = (const bf16_t*)(ws + WS_VTN);
        bf16_t* YG = (bf16_t*)(ws + WS_YG); bf16_t* YN = (bf16_t*)(ws + WS_YN);
        const float* rpb = a->in[13] + (size_t)l * 4 * 465;
        if (item < n_dft) { ph_dft(item, false, lds, wid); continue; }
        item -= n_dft;
        if (item < n_gl) { const int b = item >> 6, kvh = (item >> 5) & 1, qt = item & 31;
            attn_unit<1, false>(lds, PROJ, b, CTX + 64 * qt, 128 + kvh * 256, kvh * 64, VTG + (size_t)(b * 2 + kvh) * 64 * TB, 4, 36, YG, 512, kvh * 256, rpb, 0, wid); continue; }
        item -= n_gl;
        if (item < n_nl) { const int b = item >> 5, r = item & 31, rs = min(max(r - 4, 0), 24);
            attn_unit<4, true>(lds, PROJ, b, CTX + 64 * r, 640, 896, VTN + (size_t)(b * 4) * 64 * TB, 4 + rs, 12 + rs, YN, 256, 0, rpb, r, wid); continue; }
        item -= n_nl;
        if (item < n_dc) { ph_dft(item, true, lds, wid); continue; }
        item -= n_dc;
        if (item < n_gc) { const int b = item >> 3, kvh = (item >> 2) & 1, qt = item & 3;
            attn_unit<1, false>(lds, PROJ, b, 64 * qt, 128 + kvh * 256, kvh * 64, VTG + (size_t)(b * 2 + kvh) * 64 * TB, 4, 4, YG, 512, kvh * 256, rpb, 0, wid); continue; }
        item -= n_gc;
        { const int b = item >> 2, qt = item & 3;
            attn_unit<4, false>(lds, PROJ, b, 64 * qt, 640, 896, VTN + (size_t)(b * 4) * 64 * TB, 4, 4, YN, 256, 0, rpb, 0, wid); }
    }
}

#define XB_TMO      128
#define XB_XCNT(j)  (256  + 64 * (j))
#define XB_XSUB(j)  (1280 + 64 * (j))
#define XB_XGEN(j)  (2304 + 64 * (j))
#define XB_TOP      3328
#define XB_TOPGEN   3392
#define XCD_BAR_WORDS 3456
#define XB_SPIN_CAP (1u << 22)
constexpr int CW_BAR = 1024;
__device__ __forceinline__ unsigned xb_ld(unsigned* p)              { return __hip_atomic_load(p, __ATOMIC_RELAXED, __HIP_MEMORY_SCOPE_AGENT); }
__device__ __forceinline__ unsigned xb_add(unsigned* p, unsigned v) { return __hip_atomic_fetch_add(p, v, __ATOMIC_RELAXED, __HIP_MEMORY_SCOPE_AGENT); }
__device__ __forceinline__ unsigned xb_xcc_id() { return (unsigned)__builtin_amdgcn_s_getreg((3 << 11) | 20) & 0xFu; }
#define XB_SPIN(cond, bar) do { unsigned _sp = 0; while (cond) { __builtin_amdgcn_s_sleep(1); \
    if ((++_sp & 255u) == 0u) { if (xb_ld(&(bar)[XB_TMO])) break; if (_sp > XB_SPIN_CAP) { atomicAdd(&(bar)[XB_TMO], 1u); break; } } } } while (0)
__device__ __forceinline__ void xcd_barrier_complete(unsigned* bar, unsigned x, unsigned& nloc, unsigned& nx) {
    const unsigned G = gridDim.x;
    unsigned sum, cnt, mine, sp = 0u;
    for (;;) {
        sum = 0u; cnt = 0u; mine = 0u;
#pragma unroll
        for (unsigned j = 0; j < 16; ++j) { const unsigned c = xb_ld(&bar[XB_XCNT(j)]); sum += c; cnt += (c > 0u) ? 1u : 0u; mine = (j == x) ? c : mine; }
        if (sum == G) break;
        __builtin_amdgcn_s_sleep(1);
        if ((++sp & 255u) == 0u) { if (xb_ld(&bar[XB_TMO])) break; if (sp > XB_SPIN_CAP) { atomicAdd(&bar[XB_TMO], 1u); break; } }
    }
    nloc = mine > 0u ? mine : 1u; nx = cnt > 0u ? cnt : 1u;
}
__device__ __forceinline__ void gsync(LAS unsigned char* lds, const int wid) {
    asm volatile("s_waitcnt vmcnt(0)" ::: "memory");
    __syncthreads();
    if (opaque_tid(wid) == 0) {
        unsigned* bar = (unsigned*)(kargs()->ws + WS_CTL) + CW_BAR;
        volatile LAS unsigned* st = (volatile LAS unsigned*)(lds + LDS_RING + 64);
        const unsigned x = xb_xcc_id();
        __builtin_amdgcn_s_waitcnt(0);
        unsigned nloc = st[0], nx = st[1];
        if (nloc == 0u) { xcd_barrier_complete(bar, x, nloc, nx); st[0] = nloc; st[1] = nx; }
        const unsigned old = xb_add(&bar[XB_XSUB(x)], 1u);
        const unsigned gen = old / nloc;
        if (old + 1u == (gen + 1u) * nloc) {
            __builtin_amdgcn_fence(__ATOMIC_RELEASE, "agent");
            asm volatile("s_waitcnt vmcnt(0)" ::: "memory");
            const unsigned og = xb_add(&bar[XB_TOP], 1u);
            const unsigned tg = og / nx;
            if (og + 1u == (tg + 1u) * nx) xb_add(&bar[XB_TOPGEN], 1u);
            else XB_SPIN(xb_ld(&bar[XB_TOPGEN]) == tg, bar);
            __builtin_amdgcn_fence(__ATOMIC_ACQUIRE, "agent");
            xb_add(&bar[XB_XGEN(x)], 1u);
            asm volatile("s_waitcnt vmcnt(0)" ::: "memory");
        } else {
            XB_SPIN(xb_ld(&bar[XB_XGEN(x)]) == gen, bar);
            __builtin_amdgcn_fence(__ATOMIC_ACQUIRE, "agent");
            asm volatile("s_waitcnt vmcnt(0)" ::: "memory");
        }
    }
    __syncthreads();
}

__device__ __forceinline__ void subsync(int word, unsigned n, const int wid) {
    asm volatile("s_waitcnt vmcnt(0)" ::: "memory");
    __syncthreads();
    if (opaque_tid(wid) == 0) {
        unsigned* w = (unsigned*)(kargs()->ws + WS_CTL) + 512 + 64 * word;
        __builtin_amdgcn_fence(__ATOMIC_RELEASE, "agent");
        asm volatile("s_waitcnt vmcnt(0)" ::: "memory");
        xb_add(w, 1u);
        while (xb_ld(w) < n) __builtin_amdgcn_s_sleep(2);
        __builtin_amdgcn_fence(__ATOMIC_ACQUIRE, "agent");
        asm volatile("s_waitcnt vmcnt(0)" ::: "memory");
    }
    __syncthreads();
}
__device__ __forceinline__ void seam_x(int l, int which, bool first, int seam, LAS unsigned char* lds, const int wid) {
    if (blockIdx.x < 64) { ph_resid(l, which, first, 2, lds, wid); subsync(seam, 64u, wid); norm_rows(l, which + 1, false, 2, wid, 0, 64); }
    else norm_rows(l, which + 1, false, 1, wid, 64, (int)gridDim.x - 64);
}

__device__ __forceinline__ void seam_layer(LAS unsigned char* lds, const int wid) {
    if (blockIdx.x < 64) { ph_resid(0, 2, false, 2, lds, wid); subsync(3, 64u, wid); norm_rows(1, 0, false, 2, wid, 0, 64); }
    else { convert_weights(1, lds, wid, 64, (int)gridDim.x - 64, 1); norm_rows(1, 0, false, 1, wid, 64, (int)gridDim.x - 64); }
}

template <int l> __device__ __forceinline__ void layer_body(LAS unsigned char* lds, const int wid) {
        const int lat = l;
        if (l == 0) { norm_rows(0, 0, true, 0, wid); gsync(lds, wid); }
        if (l == 1) { convert_weights(1, lds, wid, 0, 0, 2); __syncthreads(); }
        ph_ffn_in(0, 0, lds, wid);
        gsync(lds, wid);
        ph_resid(l, 0, l == 0, 1, lds, wid);
        gsync(lds, wid);
        seam_x(l, 0, l == 0, l, lds, wid);
        gsync(lds, wid);
        ph_inproj(lds, wid);
        gsync(lds, wid);
        qk_post(l, wid);
        gsync(lds, wid);
        ph_mixers(l, lds, wid);
        gsync(lds, wid);
        ph_gates(lat, lds, wid);
        gsync(lds, wid);
        ph_merge<0>(lat, lds, wid); ph_merge<1>(lat, lds, wid); ph_merge<2>(lat, lds, wid);
        gsync(lds, wid);
        ph_resid(l, 1, false, 1, lds, wid);
        gsync(lds, wid);
        if (l == 0) seam_x(l, 1, false, 2, lds, wid);
        else norm_rows(l, 2, false, 1, wid);
        gsync(lds, wid);
        ph_ffn_in(1, lat, lds, wid);
        gsync(lds, wid);
        ph_resid(l, 2, false, 1, lds, wid);
        gsync(lds, wid);
        if (l == 0) { seam_layer(lds, wid); gsync(lds, wid); }
}

__global__ void __launch_bounds__(512, 2) mega_fwd(Args a_unused) {
    extern __shared__ __attribute__((aligned(16))) unsigned char lds_raw[];
    LAS unsigned char* lds = (LAS unsigned char*)lds_raw;
    const int wid = __builtin_amdgcn_readfirstlane((int)threadIdx.x >> 6);
    if (threadIdx.x < 16) ((LAS unsigned*)(lds + LDS_RING))[threadIdx.x + 16] = 0u;
    if (threadIdx.x == 0) (void)xb_add((unsigned*)(kargs()->ws + WS_CTL) + CW_BAR + XB_XCNT(xb_xcc_id()), 1u);
    cg::this_grid().sync();
    convert_weights(0, lds, wid);
    dft_tables(wid);
    __syncthreads();
    mod_vectors(lds, wid);
    gsync(lds, wid);
    layer_body<0>(lds, wid);
    layer_body<1>(lds, wid);
    final_norm(wid);
}

extern "C" void kernel_launch(void* const* d_in, const int* in_sizes, int n_in, void* d_out, int out_size, void* d_ws, size_t ws_size, hipStream_t stream) {
    static int grid = 0;
    if (grid == 0) {
        if (n_in != 22 || ws_size < WS_END) { fprintf(stderr, "kernel_launch: need 22 inputs and %zu bytes of workspace (got %d, %zu)\n", (size_t)WS_END, n_in, ws_size); grid = -1; return; }
        int dev = 0, cus = 0, per_cu = 0;
        (void)hipGetDevice(&dev);
        (void)hipDeviceGetAttribute(&cus, hipDeviceAttributeMultiprocessorCount, dev);
        if (hipFuncSetAttribute((const void*)mega_fwd, hipFuncAttributeMaxDynamicSharedMemorySize, LDS_BYTES) != hipSuccess) { fprintf(stderr, "kernel_launch: hipFuncSetAttribute failed\n"); grid = -1; return; }
        if (hipOccupancyMaxActiveBlocksPerMultiprocessor(&per_cu, (const void*)mega_fwd, 512, LDS_BYTES) != hipSuccess || per_cu < 1) { fprintf(stderr, "kernel_launch: occupancy query failed (%d)\n", per_cu); per_cu = 1; }
        (void)hipGetLastError();
        grid = cus * 1;
    }
    if (grid < 0) return;
    (void)hipMemsetAsync((char*)d_ws + WS_CTL, 0, 32768, stream);
    Args a{};
    for (int i = 0; i < 22; ++i) a.in[i] = (const float*)d_in[i];
    a.out = (float*)d_out; a.ws = (unsigned char*)d_ws; a.dbg = DBG; a.pad = 0;
    void* args[] = {&a};
    hipError_t e = hipLaunchCooperativeKernel((const void*)mega_fwd, dim3(grid), dim3(512), args, LDS_BYTES, stream);
    if (e != hipSuccess) fprintf(stderr, "cooperative launch failed: %s (grid %d)\n", hipGetErrorString(e), grid);
}
```

```cpp
#include <hip/hip_runtime.h>
#include <hip/hip_cooperative_groups.h>
#include <cstdio>
#include <cstdint>
namespace cg = cooperative_groups;

#define LAS __attribute__((address_space(3)))
typedef unsigned short bf16_t;
typedef short bf16x8 __attribute__((ext_vector_type(8)));
typedef float f32x4 __attribute__((ext_vector_type(4)));
typedef float f32x16 __attribute__((ext_vector_type(16)));
typedef unsigned u32x4 __attribute__((ext_vector_type(4)));
typedef unsigned u32x2 __attribute__((ext_vector_type(2)));

constexpr int D = 1024, NBATCH = 16, SEQ = 2048, CTX = 256, TB = SEQ + CTX  , MT = NBATCH * TB  ;
constexpr int DFF = 2816, NMOD = 9216, NPROJ = 2048  , NGATE = 3072, PW = 1152  ;
constexpr int INW = 4864;
constexpr float EPS = 1e-6f;
constexpr float LOG2E = 1.4426950408889634f;
constexpr float QSCALE = 0.125f * LOG2E;

constexpr size_t MiB = 1u << 20;
constexpr size_t WS_CTL = 0;
constexpr size_t WS_MOD = 1 * MiB;
constexpr size_t WS_DFTC = 3 * MiB;
constexpr size_t WS_DFT = 4 * MiB;
constexpr size_t WS_W = 20 * MiB;
constexpr size_t W_FFN1_IN = WS_W, W_FFN1_OUT = W_FFN1_IN + 11 * MiB, W_FFN2_IN = W_FFN1_OUT + 11 * MiB / 2, W_FFN2_OUT = W_FFN2_IN + 11 * MiB;
constexpr size_t W_INP = W_FFN2_OUT + 11 * MiB / 2, W_GATE = W_INP + 4 * MiB, W_FOUR = W_GATE + 6 * MiB, W_GQAO = W_FOUR + MiB / 2, W_NAO = W_GQAO + MiB, W_O = W_NAO + MiB / 2;
constexpr size_t WS_XC = 67 * MiB;
constexpr size_t WS_U = 83 * MiB;
constexpr size_t WS_YF = 155 * MiB;
constexpr size_t WS_YG = 173 * MiB;
constexpr size_t WS_YN = 209 * MiB;
constexpr size_t WS_PQT = 227 * MiB;
constexpr size_t WS_PQTC = 259 * MiB;
constexpr size_t WS_VTG = 263 * MiB;
constexpr size_t WS_VTN = 272 * MiB;
constexpr size_t WS_BIG = 290 * MiB;
constexpr size_t WS_END = 506 * MiB;
static_assert(W_O + 2 * MiB <= WS_XC, "weights");
static_assert(WS_BIG + (size_t)MT * NGATE * 2 <= WS_END, "big");

constexpr int LDS_RING = 131072;
constexpr int LDS_RPB = LDS_RING + 256;
constexpr int LDS_BYTES = LDS_RPB + 4 * 15 * 32 * 4;

typedef float f32x2_t __attribute__((ext_vector_type(2))); typedef __bf16 bf16x2_t __attribute__((ext_vector_type(2)));
__device__ __forceinline__ unsigned cvt_pk_bf16(float lo, float hi) { const f32x2_t v = {lo, hi}; const bf16x2_t b = __builtin_convertvector(v, bf16x2_t); return __builtin_bit_cast(unsigned, b); }
__device__ __forceinline__ float bf2f(unsigned short b) { return __uint_as_float(((unsigned)b) << 16); }
__device__ __forceinline__ float bflo(unsigned w) { return __uint_as_float(w << 16); }
__device__ __forceinline__ float bfhi(unsigned w) { return __uint_as_float(w & 0xffff0000u); }
__device__ __forceinline__ float fexp2(float x) { return __builtin_amdgcn_exp2f(x); }
__device__ __forceinline__ float frcp(float x) { return __builtin_amdgcn_rcpf(x); }
__device__ __forceinline__ float sigmoidf_(float x) { return frcp(1.0f + fexp2(-x * LOG2E)); }
__device__ __forceinline__ float shx(float v, int m, int lane) { return __builtin_bit_cast(float, __builtin_amdgcn_ds_bpermute((lane ^ m) << 2, __builtin_bit_cast(int, v))); }
__device__ __forceinline__ float wave_sum(float v, int lane) {
#pragma unroll
    for (int o = 1; o < 64; o <<= 1) v += shx(v, o, lane);
    return v;
}
#define LDS_WAIT() asm volatile("s_waitcnt lgkmcnt(0)" ::: "memory")
__device__ __forceinline__ int opaque_tid(int wid) { int t; asm volatile("v_mbcnt_lo_u32_b32 %0, -1, 0\n\tv_mbcnt_hi_u32_b32 %0, -1, %0" : "=v"(t)); return wid * 64 + t; }

namespace pg8 {
constexpr int BM = 256, BK = 64, HALF = 128, HTB = HALF * BK * 2, NXCD = 8, WGM = 8;
__device__ __forceinline__ int lds_byte(int r, int c) { const int st = (r >> 4) * 2 + (c >> 5), rr = r & 15, cc = c & 31, ob = rr * 64 + cc * 2; return st * 1024 + (ob ^ (((ob >> 9) & 1) << 5)); }
__device__ __forceinline__ void stage_rc(int b, int& R, int& C) { const int st = b / 1024, sb = b % 1024, swz = sb ^ (((sb >> 9) & 1) << 5); R = (st >> 1) * 16 + swz / 64; C = (st & 1) * 32 + (swz % 64) / 2; }
__device__ __forceinline__ int perm32(int rho) { const int n = rho >> 4, i = rho & 15; return 8 * (i >> 2) + 4 * n + (i & 3); }
struct Unit { int pm, pn; };
struct Gemm { const bf16_t* A; const bf16_t* Bt; int M, N, K; };
struct StaticOrder {
    int nM, nN, nwg, G, c, lat;
    __device__ void init(int M, int N, int G_, int c_, int lat_ = 0) { lat = lat_; nM = lat ? (M / BM / 9) * 8 : M / BM; nN = N / BM; nwg = nM * nN; G = G_; c = c_; }
    __device__ bool next(int i, Unit& u) const {
        const long L = (long)i * G + c; if (L >= nwg) return false;
        int wgid = (int)L; { const int q = nwg / NXCD, r = nwg % NXCD, xcd = wgid % NXCD, off = wgid / NXCD; wgid = (xcd < r ? xcd * (q + 1) : r * (q + 1) + (xcd - r) * q) + off; }
        const int nig = WGM * nN, gid = wgid / nig, fm = gid * WGM, gsz = (nM - fm) < WGM ? (nM - fm) : WGM;
        u.pm = fm + ((wgid % nig) % gsz); u.pn = (wgid % nig) / gsz;
        if (lat) u.pm = (u.pm >> 3) * 9 + 1 + (u.pm & 7);
        return true;
    }
};
struct OneUnit {
    int pm, pn;
    __device__ bool next(int i, Unit& u) const { if (i) return false; u.pm = pm; u.pn = pn; return true; }
};

template <class Epi, class Sched>
__device__ __forceinline__ void gemm_phase(LAS unsigned char* lds, const Gemm g, const Sched& S, const Epi& E, const int wid) {
    const int tid = opaque_tid(wid), lane = tid & 63, wr = wid >> 2, wc = wid & 3, fr = lane & 15, fq = lane >> 4;
    const int K = g.K, nt = K / BK;
    unsigned voffA[2], voffB[2];
#pragma unroll
    for (int i = 0; i < 2; ++i) { int R, C; stage_rc(tid * 16 + i * 8192, R, C); const int Rb = Epi::PERM ? ((R & ~31) + perm32(R & 31)) : R;
        voffA[i] = (unsigned)(R * K + C) * 2u; voffB[i] = (unsigned)(Rb * K + C) * 2u; }
    const size_t kstep = (size_t)(BK * 2);
    const size_t hstep = (size_t)HALF * K * 2;
    const size_t tstep = 2 * hstep;
    const unsigned ldsw = (unsigned)wid * 1024u;
    const int aoff = lds_byte(wr * 64 + fr, fq * 8), boff = lds_byte(wc * 32 + fr, fq * 8);
#define PG8_SA(b, h) (((b) * 2 + (h)) * HTB)
#define PG8_SB(b, h) ((4 + (b) * 2 + (h)) * HTB)
#define PG8_STAGE(bufoff, gbase, voff) do { _Pragma("unroll") for (int _i = 0; _i < 2; ++_i) \
        __builtin_amdgcn_global_load_lds((const unsigned*)((const char*)(gbase) + (voff)[_i]), (LAS unsigned*)(lds + (bufoff) + ldsw + _i * 8192), 16, 0, 0); } while (0)
#define PG8_LDA(dst, b, h) do { _Pragma("unroll") for (int m = 0; m < 4; ++m) _Pragma("unroll") for (int k = 0; k < 2; ++k) dst[m][k] = *(const LAS bf16x8*)(lds + PG8_SA(b, h) + aoff + m * 2048 + k * 1024); } while (0)
#define PG8_LDB(dst, b, h) do { _Pragma("unroll") for (int n = 0; n < 2; ++n) _Pragma("unroll") for (int k = 0; k < 2; ++k) dst[n][k] = *(const LAS bf16x8*)(lds + PG8_SB(b, h) + boff + n * 2048 + k * 1024); } while (0)
#define PG8_MMA(ai, bj, At, Bt) do { __builtin_amdgcn_s_setprio(1); _Pragma("unroll") for (int m = 0; m < 4; ++m) _Pragma("unroll") for (int n = 0; n < 2; ++n) _Pragma("unroll") for (int k = 0; k < 2; ++k) \
        acc[ai][bj][m][n] = __builtin_amdgcn_mfma_f32_16x16x32_bf16(Bt[n][k], At[m][k], acc[ai][bj][m][n], 0, 0, 0); __builtin_amdgcn_s_setprio(0); } while (0)
#define PG8_WAIT_V(n) asm volatile("s_waitcnt vmcnt(" #n ")" ::: "memory")
#define PG8_WAIT_L(n) asm volatile("s_waitcnt lgkmcnt(" #n ")" ::: "memory")
#define PG8_BAR __builtin_amdgcn_s_barrier()
#define PG8_SCHED __builtin_amdgcn_sched_barrier(0)
    Unit cur, nxt; int ui = 0;
    if (!S.next(0, cur)) return;
    f32x4 acc[2][2][4][2];
#pragma unroll
    for (int a = 0; a < 2; ++a)
#pragma unroll
        for (int b = 0; b < 2; ++b)
#pragma unroll
            for (int m = 0; m < 4; ++m)
#pragma unroll
                for (int n = 0; n < 2; ++n) acc[a][b][m][n] = (f32x4){0.f, 0.f, 0.f, 0.f};
    bf16x8 At[4][2], B0[2][2], B1[2][2];
    const char* cA = (const char*)g.A + (size_t)cur.pm * tstep; const char* cB = (const char*)g.Bt + (size_t)cur.pn * tstep;
    PG8_STAGE(PG8_SB(0, 0), cB, voffB); PG8_STAGE(PG8_SB(0, 1), cB + hstep, voffB); PG8_STAGE(PG8_SA(0, 0), cA, voffA); PG8_STAGE(PG8_SA(0, 1), cA + hstep, voffA);
    if (wr == 1) PG8_BAR;
    PG8_WAIT_V(2); PG8_BAR;
    PG8_STAGE(PG8_SB(1, 0), cB + kstep, voffB); PG8_STAGE(PG8_SA(1, 0), cA + kstep, voffA); PG8_STAGE(PG8_SB(1, 1), cB + hstep + kstep, voffB);
    PG8_WAIT_V(6); PG8_BAR;
    for (;;) {
        const bool has_next = S.next(ui + 1, nxt);
        const char* nA = has_next ? (const char*)g.A + (size_t)nxt.pm * tstep : cA; const char* nB = has_next ? (const char*)g.Bt + (size_t)nxt.pn * tstep : cB;
        for (int t = 0; t < nt; t += 2) {
            const bool last = (t == nt - 2);
            const char* a1 = cA + (size_t)(t + 1) * kstep;
            const char* a2 = last ? nA : cA + (size_t)(t + 2) * kstep; const char* b2 = last ? nB : cB + (size_t)(t + 2) * kstep;
            const char* a3 = a2 + kstep; const char* b3 = b2 + kstep;
            PG8_LDB(B0, 0, 0); PG8_LDB(B1, 0, 1); PG8_SCHED; PG8_LDA(At, 0, 0); PG8_STAGE(PG8_SA(1, 1), a1 + hstep, voffA);
            PG8_WAIT_V(8); PG8_WAIT_L(0); PG8_BAR; PG8_MMA(0, 0, At, B0); PG8_MMA(0, 1, At, B1); PG8_BAR; PG8_SCHED;
            PG8_LDA(At, 0, 1); PG8_STAGE(PG8_SB(0, 0), b2, voffB); PG8_STAGE(PG8_SB(0, 1), b2 + hstep, voffB); PG8_STAGE(PG8_SA(0, 0), a2, voffA);
            PG8_WAIT_V(8); PG8_WAIT_L(0); PG8_BAR; PG8_MMA(1, 0, At, B0); PG8_MMA(1, 1, At, B1); PG8_BAR; PG8_SCHED;
            PG8_LDB(B0, 1, 0); PG8_LDB(B1, 1, 1); PG8_SCHED; PG8_LDA(At, 1, 0); PG8_STAGE(PG8_SA(0, 1), a2 + hstep, voffA);
            PG8_WAIT_V(8); PG8_WAIT_L(0); PG8_BAR; PG8_MMA(0, 0, At, B0); PG8_MMA(0, 1, At, B1); PG8_BAR; PG8_SCHED;
            PG8_LDA(At, 1, 1); PG8_STAGE(PG8_SB(1, 0), b3, voffB); PG8_STAGE(PG8_SB(1, 1), b3 + hstep, voffB); PG8_STAGE(PG8_SA(1, 0), a3, voffA);
            PG8_WAIT_V(8); PG8_WAIT_L(0); PG8_BAR; PG8_MMA(1, 0, At, B0); PG8_MMA(1, 1, At, B1); PG8_BAR; PG8_SCHED;
        }
        if (wr == 0) PG8_BAR;
        { int ln = tid; asm volatile("" : "+v"(ln)); E(acc, cur, wr, wc, ln & 15, (ln >> 4) & 3); }
        if (!has_next) break;
#pragma unroll
        for (int a = 0; a < 2; ++a)
#pragma unroll
            for (int b = 0; b < 2; ++b)
#pragma unroll
                for (int m = 0; m < 4; ++m)
#pragma unroll
                    for (int n = 0; n < 2; ++n) acc[a][b][m][n] = (f32x4){0.f, 0.f, 0.f, 0.f};
        cur = nxt; cA = nA; cB = nB; ++ui;
        if (wr == 1) PG8_BAR;
    }
    PG8_WAIT_V(0);
    PG8_BAR;
#undef PG8_SA
#undef PG8_SB
#undef PG8_STAGE
#undef PG8_LDA
#undef PG8_LDB
#undef PG8_MMA
#undef PG8_WAIT_V
#undef PG8_WAIT_L
#undef PG8_BAR
#undef PG8_SCHED
}
}
using pg8::Unit;
typedef f32x4 AccT[2][2][4][2];


#define GPTR(T, base, off) ((T*)((char*)(base) + (unsigned)(off)))
#define GCPTR(T, base, off) ((const T*)((const char*)(base) + (unsigned)(off)))
struct EpiSwiglu {
    static constexpr bool PERM = true;
    bf16_t* H;
    __device__ __forceinline__ void operator()(const AccT& acc, const Unit& u, int wr, int wc, int fr, int fq) const {
        const unsigned o0 = (unsigned)((u.pm * 256 + wr * 64 + fr) * DFF + u.pn * 128 + wc * 32 + 8 * fq) * 2u;
#pragma unroll
        for (int ai = 0; ai < 2; ++ai)
#pragma unroll
            for (int m = 0; m < 4; ++m) {
                float h[8];
#pragma unroll
                for (int n = 0; n < 2; ++n)
#pragma unroll
                    for (int j = 0; j < 4; ++j) { const float a = acc[ai][0][m][n][j], g = acc[ai][1][m][n][j]; h[n * 4 + j] = a * g * sigmoidf_(g); }
                u32x4 w; w.x = cvt_pk_bf16(h[0], h[1]); w.y = cvt_pk_bf16(h[2], h[3]); w.z = cvt_pk_bf16(h[4], h[5]); w.w = cvt_pk_bf16(h[6], h[7]);
                *GPTR(u32x4, H, o0 + (unsigned)((ai * 128 + m * 16) * DFF * 2)) = w;
            }
    }
};
struct EpiResid {
    static constexpr bool PERM = false;
    const float* inL; const float* inC; float* outL; float* outC; const float* gate  ; float fac;
    __device__ __forceinline__ void operator()(const AccT& acc, const Unit& u, int wr, int wc, int fr, int fq) const {
        const int b = u.pm / 9, tt = u.pm - b * 9;
        const float* ib; float* ob; const float* g;
        if (tt == 0) { ib = inC + (size_t)b * 256 * D; ob = outC + (size_t)b * 256 * D; g = gate + 16 * NMOD; }
        else { const size_t o = ((size_t)b * SEQ + (tt - 1) * 256) * D; ib = inL + o; ob = outL + o; g = gate + b * NMOD; }
        const int col0 = u.pn * 256 + wc * 32 + 4 * fq;
        f32x4 gv[2][2];
#pragma unroll
        for (int bj = 0; bj < 2; ++bj)
#pragma unroll
            for (int n = 0; n < 2; ++n) gv[bj][n] = *GCPTR(f32x4, g, (col0 + bj * 128 + n * 16) * 4) * fac;
        const unsigned o0 = (unsigned)((wr * 64 + fr) * D + col0) * 4u;
#pragma unroll
        for (int ai = 0; ai < 2; ++ai) {
            f32x4 xv[4][2][2];
#pragma unroll
            for (int m = 0; m < 4; ++m)
#pragma unroll
                for (int bj = 0; bj < 2; ++bj)
#pragma unroll
                    for (int n = 0; n < 2; ++n) xv[m][bj][n] = *GCPTR(f32x4, ib, o0 + (unsigned)(((ai * 128 + m * 16) * D + bj * 128 + n * 16) * 4));
#pragma unroll
            for (int m = 0; m < 4; ++m)
#pragma unroll
                for (int bj = 0; bj < 2; ++bj)
#pragma unroll
                    for (int n = 0; n < 2; ++n) *GPTR(f32x4, ob, o0 + (unsigned)(((ai * 128 + m * 16) * D + bj * 128 + n * 16) * 4)) = xv[m][bj][n] + gv[bj][n] * acc[ai][bj][m][n];
            asm volatile("" ::: "memory");
        }
    }
};
struct EpiInProj {
    static constexpr bool PERM = false;
    bf16_t *PQT, *PQTC, *VTG, *VTN, *PROJ;
    __device__ __forceinline__ void operator()(const AccT& acc, const Unit& u, int wr, int wc, int fr, int fq) const {
        const int b = u.pm / 9, tt = u.pm - b * 9;
        const int tbase = tt * 256 + wr * 64 + fr;
#pragma unroll
        for (int bj = 0; bj < 2; ++bj) {
            const int hh = 2 * u.pn + bj;
            if (hh >= 7) {
                const float sc = (hh == 12 || hh == 13) ? QSCALE : 1.0f;
                const unsigned o0 = (unsigned)((b * TB + tbase) * PW + (hh - 7) * 128 + wc * 32 + 4 * fq) * 2u;
#pragma unroll
                for (int ai = 0; ai < 2; ++ai)
#pragma unroll
                    for (int m = 0; m < 4; ++m)
#pragma unroll
                        for (int n = 0; n < 2; ++n) { const f32x4 v = acc[ai][bj][m][n] * sc; u32x2 w; w.x = cvt_pk_bf16(v[0], v[1]); w.y = cvt_pk_bf16(v[2], v[3]);
                            *GPTR(u32x2, PROJ, o0 + (unsigned)(((ai * 128 + m * 16) * PW + n * 16) * 2)) = w; }
            } else {
                bf16_t* base; int pitch; int t0;
                if (hh < 4) {
                    const int pq = hh >> 1, ch0 = (hh & 1) * 128;
                    if (tt == 0) { base = PQTC + ((size_t)b * 256 + ch0) * 512 + pq * 256; pitch = 512; t0 = tbase; }
                    else { base = PQT + ((size_t)b * 256 + ch0) * 4096 + pq * 2048; pitch = 4096; t0 = tbase - 256; }
                } else { const int frs = fr ^ ((((fr >> 2) ^ (fr >> 3)) & 1) * 12);
                    if (hh == 4) { base = VTG + (size_t)b * 128 * TB; pitch = TB; t0 = tbase - fr + frs; }
                    else { base = VTN + ((size_t)b * 256 + (hh - 5) * 128) * TB; pitch = TB; t0 = tbase - fr + frs; } }
                const unsigned o0 = (unsigned)((wc * 32 + 4 * fq) * pitch + t0) * 2u;
#pragma unroll
                for (int n = 0; n < 2; ++n)
#pragma unroll
                    for (int j = 0; j < 4; ++j) {
                        const unsigned oc = o0 + (unsigned)((n * 16 + j) * pitch) * 2u;
#pragma unroll
                        for (int ai = 0; ai < 2; ++ai)
#pragma unroll
                            for (int m = 0; m < 4; ++m) *GPTR(bf16_t, base, oc + (unsigned)((ai * 128 + m * 16) * 2)) = (bf16_t)(cvt_pk_bf16(acc[ai][bj][m][n][j], 0.f) & 0xffffu);
                    }
            }
        }
    }
};
struct EpiDft {
    static constexpr bool PERM = true;
    bf16_t* YF; int tofs; float scale;
    __device__ __forceinline__ void operator()(const AccT& acc, const Unit& u, int wr, int wc, int fr, int fq) const {
        const unsigned o0 = (unsigned)((u.pn * TB + tofs + u.pm * 256 + wr * 64 + fr) * 256 + wc * 32 + 8 * fq) * 2u;
#pragma unroll
        for (int ai = 0; ai < 2; ++ai)
#pragma unroll
            for (int m = 0; m < 4; ++m)
#pragma unroll
                for (int bj = 0; bj < 2; ++bj) { const f32x4 v0 = acc[ai][bj][m][0] * scale, v1 = acc[ai][bj][m][1] * scale;
                    u32x4 w; w.x = cvt_pk_bf16(v0[0], v0[1]); w.y = cvt_pk_bf16(v0[2], v0[3]); w.z = cvt_pk_bf16(v1[0], v1[1]); w.w = cvt_pk_bf16(v1[2], v1[3]);
                    *GPTR(u32x4, YF, o0 + (unsigned)(((ai * 128 + m * 16) * 256 + bj * 128) * 2)) = w; }
    }
};
struct EpiGates {
    static constexpr bool PERM = true;
    bf16_t* Gt;
    __device__ __forceinline__ void operator()(const AccT& acc, const Unit& u, int wr, int wc, int fr, int fq) const {
        const unsigned o0 = (unsigned)((u.pm * 256 + wr * 64 + fr) * NGATE + u.pn * 256 + wc * 32 + 8 * fq) * 2u;
#pragma unroll
        for (int ai = 0; ai < 2; ++ai)
#pragma unroll
            for (int m = 0; m < 4; ++m)
#pragma unroll
                for (int bj = 0; bj < 2; ++bj) { float s[8];
#pragma unroll
                    for (int n = 0; n < 2; ++n)
#pragma unroll
                        for (int j = 0; j < 4; ++j) s[n * 4 + j] = sigmoidf_(acc[ai][bj][m][n][j]);
                    u32x4 w; w.x = cvt_pk_bf16(s[0], s[1]); w.y = cvt_pk_bf16(s[2], s[3]); w.z = cvt_pk_bf16(s[4], s[5]); w.w = cvt_pk_bf16(s[6], s[7]);
                    *GPTR(u32x4, Gt, o0 + (unsigned)(((ai * 128 + m * 16) * NGATE + bj * 128) * 2)) = w; }
    }
};
template <bool FIRST> struct EpiMerge {
    static constexpr bool PERM = true;
    const bf16_t* Gt  ; bf16_t* Mg;
    __device__ __forceinline__ void operator()(const AccT& acc, const Unit& u, int wr, int wc, int fr, int fq) const {
        const int row0 = u.pm * 256 + wr * 64 + fr, col0 = u.pn * 256 + wc * 32 + 8 * fq;
        const unsigned og0 = (unsigned)(row0 * NGATE + col0) * 2u, om0 = (unsigned)(row0 * D + col0) * 2u;
#pragma unroll
        for (int ai = 0; ai < 2; ++ai) {
            u32x4 gwv[4][2], owv[4][2];
#pragma unroll
            for (int m = 0; m < 4; ++m)
#pragma unroll
                for (int bj = 0; bj < 2; ++bj) {
                    gwv[m][bj] = *GCPTR(u32x4, Gt, og0 + (unsigned)(((ai * 128 + m * 16) * NGATE + bj * 128) * 2));
                    if (!FIRST) owv[m][bj] = *GCPTR(u32x4, Mg, om0 + (unsigned)(((ai * 128 + m * 16) * D + bj * 128) * 2));
                    else owv[m][bj] = (u32x4){0u, 0u, 0u, 0u};
                }
#pragma unroll
            for (int m = 0; m < 4; ++m)
#pragma unroll
                for (int bj = 0; bj < 2; ++bj) {
                    const u32x4 gw = gwv[m][bj], ow = owv[m][bj];
                    const f32x4 a0 = acc[ai][bj][m][0], a1 = acc[ai][bj][m][1];
                    float o[8];
                    o[0] = bflo(ow.x) + bflo(gw.x) * a0[0]; o[1] = bfhi(ow.x) + bfhi(gw.x) * a0[1];
                    o[2] = bflo(ow.y) + bflo(gw.y) * a0[2]; o[3] = bfhi(ow.y) + bfhi(gw.y) * a0[3];
                    o[4] = bflo(ow.z) + bflo(gw.z) * a1[0]; o[5] = bfhi(ow.z) + bfhi(gw.z) * a1[1];
                    o[6] = bflo(ow.w) + bflo(gw.w) * a1[2]; o[7] = bfhi(ow.w) + bfhi(gw.w) * a1[3];
                    u32x4 w; w.x = cvt_pk_bf16(o[0], o[1]); w.y = cvt_pk_bf16(o[2], o[3]); w.z = cvt_pk_bf16(o[4], o[5]); w.w = cvt_pk_bf16(o[6], o[7]);
                    *GPTR(u32x4, Mg, om0 + (unsigned)(((ai * 128 + m * 16) * D + bj * 128) * 2)) = w;
                }
            asm volatile("" ::: "memory");
        }
    }
};

#define MFMA32(a, b, c) __builtin_amdgcn_mfma_f32_32x32x16_bf16((a), (b), (c), 0, 0, 0)
template <int NS, bool MASK>
__device__ __forceinline__ void attn_unit(LAS unsigned char* lds, const bf16_t* proj, int b, int t0, int qcol0, int kcol0, const bf16_t* vt0, int l0, int l1,
                                          bf16_t* Y, int ldy, int ycol0, const float* rpb, int qrow, const int wid) {
    const int tid = opaque_tid(wid), lane = tid & 63, r32 = lane & 31, hi = lane >> 5;
    const int g = wid >> 1, half = wid & 1, slot = (NS == 1) ? 0 : g;
    const size_t rowb = (size_t)b * TB;
    bf16x8 qr[4];
    { const bf16_t* qp = proj + (rowb + t0 + 32 * half + r32) * PW + qcol0 + g * 64 + 8 * hi;
#pragma unroll
      for (int d0 = 0; d0 < 4; ++d0) qr[d0] = *(const bf16x8*)(qp + 16 * d0); }
    const int lrow = tid >> 3, lch = tid & 7;
    const bf16_t* ksrc = proj + (rowb + lrow) * PW + kcol0 + lch * 8;
    const bf16_t* vsrc = vt0 + (size_t)lrow * TB + lch * 8;
    const unsigned ldst = (unsigned)(lrow * 128 + ((lch ^ ((lrow >> 1) & 7)) << 4));
    const unsigned vdst0 = (unsigned)(lrow * 128 + ((((lch & 6) + 0) ^ ((lrow >> 1) & 7)) << 4) + 8 * (lch & 1));
    const unsigned vdst1 = (unsigned)(lrow * 128 + ((((lch & 6) + 1) ^ ((lrow >> 1) & 7)) << 4) + 8 * (lch & 1));
    u32x4 kreg[NS], vreg[NS];
    const int ntile = 4 + (l1 - l0);
#define ATT_LOAD(it) do { const int kt_ = (it) < 4 ? (it) : l0 + (it) - 4; _Pragma("unroll") for (int s_ = 0; s_ < NS; ++s_) { \
        kreg[s_] = *(const u32x4*)(ksrc + (size_t)kt_ * 64 * PW + s_ * 64); vreg[s_] = *(const u32x4*)(vsrc + kt_ * 64 + (size_t)s_ * 64 * TB); } } while (0)
    constexpr int STG = NS * 16384;
#define ATT_STORE(st) do { _Pragma("unroll") for (int s_ = 0; s_ < NS; ++s_) { *(LAS u32x4*)(lds + (st) * STG + s_ * 16384 + ldst) = kreg[s_]; *(LAS u32x4*)(lds + (st) * STG + s_ * 16384 + 8192 + ldst) = vreg[s_]; } } while (0)
    const LAS unsigned char* kb0 = lds + slot * 16384 + r32 * 128;
    const LAS unsigned char* vb0 = lds + slot * 16384 + 8192 + r32 * 128;
    const int sw = (r32 >> 1) & 7;
    f32x16 o0, o1;
#pragma unroll
    for (int i = 0; i < 16; ++i) { o0[i] = 0.f; o1[i] = 0.f; }
    float mrun = -INFINITY, lsum = 0.f;
    const int qc = 32 * half + r32;
    const int cs = min(max(qc - 8, 0), 48);
    ATT_LOAD(0);
    __syncthreads();
    ATT_STORE(0);
    __syncthreads();
    for (int it = 0; it < ntile; ++it) {
        if (it + 1 < ntile) ATT_LOAD(it + 1);
        const LAS unsigned char* kb = kb0 + (it & 1) * STG;
        const LAS unsigned char* vb = vb0 + (it & 1) * STG;
        f32x16 p0, p1;
#pragma unroll
        for (int i = 0; i < 16; ++i) { p0[i] = 0.f; p1[i] = 0.f; }
#pragma unroll
        for (int d0 = 0; d0 < 4; ++d0) {
            const int co = ((2 * d0 + hi) ^ sw) << 4;
            const bf16x8 k0 = *(const LAS bf16x8*)(kb + co), k1 = *(const LAS bf16x8*)(kb + 4096 + co);
            p0 = MFMA32(k0, qr[d0], p0); p1 = MFMA32(k1, qr[d0], p1);
        }
        if (MASK && it >= 4) {
            const int dr = (l0 + it - 8) - qrow + 7;
            const LAS float* bp = (const LAS float*)(lds + LDS_RPB) + (g * 15 + dr) * 32;
#pragma unroll
            for (int r = 0; r < 16; ++r) {
                const int kc0 = (r & 3) + 8 * (r >> 2) + 4 * hi, kc1 = kc0 + 32;
                const int i0 = min(max(kc0 - qc + 15, 0), 30), i1 = min(max(kc1 - qc + 15, 0), 30);
                const float b0 = bp[i0], b1 = bp[i1];
                p0[r] = (kc0 >= cs && kc0 < cs + 16) ? p0[r] + b0 : -INFINITY;
                p1[r] = (kc1 >= cs && kc1 < cs + 16) ? p1[r] + b1 : -INFINITY;
            }
        }
        float mx = fmaxf(p0[0], p1[0]);
#pragma unroll
        for (int r = 1; r < 16; ++r) mx = fmaxf(mx, fmaxf(p0[r], p1[r]));
        mx = fmaxf(mx, shx(mx, 32, lane));
        const float mnew = fmaxf(mrun, mx);
        const float alpha = fexp2(mrun - mnew);
        mrun = mnew;
        float ps = 0.f;
#pragma unroll
        for (int r = 0; r < 16; ++r) { p0[r] = fexp2(p0[r] - mnew); p1[r] = fexp2(p1[r] - mnew); ps += p0[r] + p1[r]; }
        lsum = lsum * alpha + ps;
#pragma unroll
        for (int i = 0; i < 16; ++i) { o0[i] *= alpha; o1[i] *= alpha; }
        bf16x8 pb[4];
#pragma unroll
        for (int s = 0; s < 2; ++s) {
            u32x4 w0, w1;
            w0.x = cvt_pk_bf16(p0[8 * s + 0], p0[8 * s + 1]); w0.y = cvt_pk_bf16(p0[8 * s + 2], p0[8 * s + 3]); w0.z = cvt_pk_bf16(p0[8 * s + 4], p0[8 * s + 5]); w0.w = cvt_pk_bf16(p0[8 * s + 6], p0[8 * s + 7]);
            w1.x = cvt_pk_bf16(p1[8 * s + 0], p1[8 * s + 1]); w1.y = cvt_pk_bf16(p1[8 * s + 2], p1[8 * s + 3]); w1.z = cvt_pk_bf16(p1[8 * s + 4], p1[8 * s + 5]); w1.w = cvt_pk_bf16(p1[8 * s + 6], p1[8 * s + 7]);
            pb[s] = __builtin_bit_cast(bf16x8, w0); pb[2 + s] = __builtin_bit_cast(bf16x8, w1);
        }
#pragma unroll
        for (int ks = 0; ks < 4; ++ks) {
            const int c0 = ((2 * ks + hi) ^ sw) << 4;
            const bf16x8 va = *(const LAS bf16x8*)(vb + c0), ve = *(const LAS bf16x8*)(vb + 4096 + c0);
            o0 = MFMA32(va, pb[ks], o0);
            o1 = MFMA32(ve, pb[ks], o1);
        }
        if (it + 1 < ntile) ATT_STORE((it + 1) & 1);
        __syncthreads();
    }
    lsum += shx(lsum, 32, lane);
    const float inv = 1.0f / lsum;
    bf16_t* yp = Y + (rowb + t0 + 32 * half + r32) * ldy + ycol0 + g * 64 + 4 * hi;
#pragma unroll
    for (int rg = 0; rg < 4; ++rg) {
        u32x2 w; w.x = cvt_pk_bf16(o0[4 * rg] * inv, o0[4 * rg + 1] * inv); w.y = cvt_pk_bf16(o0[4 * rg + 2] * inv, o0[4 * rg + 3] * inv);
        *(u32x2*)(yp + 8 * rg) = w;
        u32x2 x; x.x = cvt_pk_bf16(o1[4 * rg] * inv, o1[4 * rg + 1] * inv); x.y = cvt_pk_bf16(o1[4 * rg + 2] * inv, o1[4 * rg + 3] * inv);
        *(u32x2*)(yp + 32 + 8 * rg) = x;
    }
#undef ATT_LOAD
#undef ATT_STORE
}

#ifndef DBG
#define DBG 0
#endif
struct Args { const float* in[22]; float* out; unsigned char* ws; int dbg; int pad; };
typedef const __attribute__((address_space(4))) Args* KArgs;
__device__ __forceinline__ KArgs kargs() { KArgs p = (KArgs)__builtin_amdgcn_kernarg_segment_ptr(); asm volatile("" : "+s"(p)); return p; }

__device__ __forceinline__ void cvt_item(const float* W, int ldw, int srccol0, bf16_t* WT, int K, int k0, LAS float* scr, int lane) {
#pragma unroll
    for (int i = 0; i < 32; ++i) { const int kk = 2 * i + (lane >> 5); scr[kk * 33 + (lane & 31)] = W[(size_t)(k0 + kk) * ldw + srccol0 + (lane & 31)]; }
    LDS_WAIT();
    const int c = lane & 7;
#pragma unroll
    for (int j = 0; j < 4; ++j) { const int n = (lane >> 3) + 8 * j; const LAS float* s = scr + (8 * c) * 33 + n;
        u32x4 o; o.x = cvt_pk_bf16(s[0 * 33], s[1 * 33]); o.y = cvt_pk_bf16(s[2 * 33], s[3 * 33]); o.z = cvt_pk_bf16(s[4 * 33], s[5 * 33]); o.w = cvt_pk_bf16(s[6 * 33], s[7 * 33]);
        *(u32x4*)(WT + (size_t)n * K + k0 + 8 * c) = o; }
    LDS_WAIT();
}
__device__ __forceinline__ float cos_rev(float x) { return __builtin_amdgcn_cosf(x); }
__device__ __forceinline__ float sin_rev(float x) { return __builtin_amdgcn_sinf(x); }

__device__ __forceinline__ void convert_weights(int l, LAS unsigned char* lds, const int wid, int b0 = 0, int nb = 0, int cmode = 0) {
    KArgs a = kargs();
    if (nb == 0) nb = gridDim.x;
    const int tid_ = opaque_tid(wid), lane = tid_ & 63, gw = ((int)blockIdx.x - b0) * 8 + wid, NGW = nb * 8;
    unsigned char* ws = a->ws;
    LAS float* scr = (LAS float*)(lds + wid * 16384);
    const float* f1i = a->in[7] + (size_t)l * D * 2 * DFF; const float* f1o = a->in[8] + (size_t)l * DFF * D;
    const float* f2i = a->in[19] + (size_t)l * D * 2 * DFF; const float* f2o = a->in[20] + (size_t)l * DFF * D;
    const float* win = a->in[10] + (size_t)l * D * INW;
    const float* wf = a->in[14] + (size_t)l * 256 * D; const float* wg = a->in[15] + (size_t)l * 512 * D; const float* wn = a->in[16] + (size_t)l * 256 * D; const float* wo = a->in[17] + (size_t)l * D * D;
    constexpr int I_FI = 16 * 176, I_FO = 44 * 32, I_IP = 16 * 48, I_GT = 16 * 96, I_WF = 4 * 32, I_WG = 8 * 32, I_WN = 4 * 32, I_WO = 16 * 32, I_PQ = 32 * 8;
    constexpr int NIT = 2 * I_FI + 2 * I_FO + I_IP + I_GT + I_WF + I_WG + I_WN + I_WO + I_PQ;
    for (int it = gw; it < NIT; it += NGW) {
        int r = it;
        { const bool f2o = (it >= 2 * I_FI + I_FO) && (it < 2 * I_FI + 2 * I_FO); if ((cmode == 1 && f2o) || (cmode == 2 && !f2o)) continue; }
        if (r < 2 * I_FI) { const int which = r / I_FI; r -= which * I_FI; const int kb = r / 176, db = r % 176, p = db >> 3, w8 = db & 7;
            cvt_item(which ? f2i : f1i, 2 * DFF, (w8 >> 2) * DFF + 128 * p + 32 * (w8 & 3), (bf16_t*)(ws + (which ? W_FFN2_IN : W_FFN1_IN)) + (size_t)32 * db * D, D, 64 * kb, scr, lane); continue; }
        r -= 2 * I_FI;
        if (r < 2 * I_FO) { const int which = r / I_FO; r -= which * I_FO; const int kb = r / 32, db = r % 32;
            cvt_item(which ? f2o : f1o, D, 32 * db, (bf16_t*)(ws + (which ? W_FFN2_OUT : W_FFN1_OUT)) + (size_t)32 * db * DFF, DFF, 64 * kb, scr, lane); continue; }
        r -= 2 * I_FO;
        if (r < I_IP) { const int kb = r / 48, row0 = 512 + 32 * (r % 48); int sc;
            if (row0 < 640) sc = 896 + (row0 - 512); else if (row0 < 896) sc = 1536 + (row0 - 640); else if (row0 < 1024) sc = 768 + (row0 - 896);
            else if (row0 < 1536) sc = 256 + (row0 - 1024); else if (row0 < 1792) sc = 1024 + (row0 - 1536); else sc = 1280 + (row0 - 1792);
            cvt_item(win, INW, sc, (bf16_t*)(ws + W_INP) + (size_t)row0 * D, D, 64 * kb, scr, lane); continue; }
        r -= I_IP;
        if (r < I_GT) { const int kb = r / 96, db = r % 96; cvt_item(win, INW, 1792 + 32 * db, (bf16_t*)(ws + W_GATE) + (size_t)32 * db * D, D, 64 * kb, scr, lane); continue; }
        r -= I_GT;
        if (r < I_WF) { const int kb = r / 32, db = r % 32; cvt_item(wf, D, 32 * db, (bf16_t*)(ws + W_FOUR) + (size_t)32 * db * 256, 256, 64 * kb, scr, lane); continue; }
        r -= I_WF;
        if (r < I_WG) { const int kb = r / 32, db = r % 32; cvt_item(wg, D, 32 * db, (bf16_t*)(ws + W_GQAO) + (size_t)32 * db * 512, 512, 64 * kb, scr, lane); continue; }
        r -= I_WG;
        if (r < I_WN) { const int kb = r / 32, db = r % 32; cvt_item(wn, D, 32 * db, (bf16_t*)(ws + W_NAO) + (size_t)32 * db * 256, 256, 64 * kb, scr, lane); continue; }
        r -= I_WN;
        if (r < I_WO) { const int kb = r / 32, db = r % 32; cvt_item(wo, D, 32 * db, (bf16_t*)(ws + W_O) + (size_t)32 * db * D, D, 64 * kb, scr, lane); continue; }
        r -= I_WO;
        {
            const int kb = r >> 3, combo = r & 7, pq = combo >> 2, gq = combo & 3, k0 = 32 * kb;
#pragma unroll
            for (int i = 0; i < 32; ++i) scr[i * 65 + lane] = win[(size_t)(k0 + i) * INW + gq * 64 + lane];
            LDS_WAIT();
            float accv[32];
#pragma unroll
            for (int i = 0; i < 32; ++i) accv[i] = 0.f;
            for (int c = 0; c < 64; ++c) {
                const float ph = (float)((lane * c) & 63) * (1.0f / 64.0f);
                const float tv = pq ? sin_rev(ph) : cos_rev(ph);
#pragma unroll
                for (int i = 0; i < 32; ++i) accv[i] += scr[i * 65 + c] * tv;
            }
            bf16_t* dst = (bf16_t*)(ws + W_INP) + (size_t)(pq * 256 + gq * 64 + lane) * D + k0;
#pragma unroll
            for (int q4 = 0; q4 < 4; ++q4) { u32x4 o; o.x = cvt_pk_bf16(accv[8 * q4], accv[8 * q4 + 1]); o.y = cvt_pk_bf16(accv[8 * q4 + 2], accv[8 * q4 + 3]);
                o.z = cvt_pk_bf16(accv[8 * q4 + 4], accv[8 * q4 + 5]); o.w = cvt_pk_bf16(accv[8 * q4 + 6], accv[8 * q4 + 7]); *(u32x4*)(dst + 8 * q4) = o; }
            LDS_WAIT();
        }
    }
}

__device__ __forceinline__ void dft_tables(const int wid) {
    KArgs a = kargs(); unsigned char* ws = a->ws;
    bf16_t* DFT = (bf16_t*)(ws + WS_DFT); bf16_t* DFTC = (bf16_t*)(ws + WS_DFTC);
    const int gt = blockIdx.x * 512 + opaque_tid(wid), NT = gridDim.x * 512;
    for (int i = gt; i < 2048 * 512; i += NT) {
        const int k1 = i >> 9, c8 = (i & 511) * 8, pq = c8 >> 11, t0 = c8 & 2047; float v[8];
#pragma unroll
        for (int j = 0; j < 8; ++j) { const float ph = (float)((k1 * (t0 + j)) & 2047) * (1.0f / 2048.0f); v[j] = pq ? -sin_rev(ph) : cos_rev(ph); }
        u32x4 o; o.x = cvt_pk_bf16(v[0], v[1]); o.y = cvt_pk_bf16(v[2], v[3]); o.z = cvt_pk_bf16(v[4], v[5]); o.w = cvt_pk_bf16(v[6], v[7]);
        *(u32x4*)(DFT + (size_t)k1 * 4096 + c8) = o;
    }
    for (int i = gt; i < 256 * 64; i += NT) {
        const int k1 = i >> 6, c8 = (i & 63) * 8, pq = c8 >> 8, t0 = c8 & 255; float v[8];
#pragma unroll
        for (int j = 0; j < 8; ++j) { const float ph = (float)((k1 * (t0 + j)) & 255) * (1.0f / 256.0f); v[j] = pq ? -sin_rev(ph) : cos_rev(ph); }
        u32x4 o; o.x = cvt_pk_bf16(v[0], v[1]); o.y = cvt_pk_bf16(v[2], v[3]); o.z = cvt_pk_bf16(v[4], v[5]); o.w = cvt_pk_bf16(v[6], v[7]);
        *(u32x4*)(DFTC + (size_t)k1 * 512 + c8) = o;
    }
}

__device__ __forceinline__ void mod_vectors(LAS unsigned char* lds, const int wid) {
    KArgs a = kargs(); float* mod = (float*)(a->ws + WS_MOD);
    const int tid = opaque_tid(wid), lane = tid & 63;
    const float* cin = a->in[1]; const float* cctx = a->in[3]; const float* modw = a->in[4]; const float* modb = a->in[5];
    LAS float* S = (LAS float*)lds;
    LAS float* red = (LAS float*)(lds + 69632);
    for (int i = tid; i < 17 * 1024; i += 512) { const float cvv = i < 16 * 1024 ? cin[i] : cctx[i - 16 * 1024]; S[i] = cvv * sigmoidf_(cvv); }
    __syncthreads();
    for (int unit = blockIdx.x; unit < 288; unit += gridDim.x) {
        const int l = unit / 144, n0 = (unit % 144) * 64;
        const float* wp = modw + (size_t)l * D * NMOD + n0 + lane;
        float accm[17];
#pragma unroll
        for (int m = 0; m < 17; ++m) accm[m] = 0.f;
        const int kbeg = wid * 128;
#pragma unroll 8
        for (int k = kbeg; k < kbeg + 128; ++k) {
            const float wv = wp[(size_t)k * NMOD];
#pragma unroll
            for (int m = 0; m < 17; ++m) accm[m] += S[m * 1024 + k] * wv;
        }
#pragma unroll
        for (int m = 0; m < 17; ++m) red[(wid * 17 + m) * 64 + lane] = accm[m];
        __syncthreads();
        for (int i = tid; i < 17 * 64; i += 512) {
            const int m = i >> 6, c = i & 63; float s = modb[(size_t)l * NMOD + n0 + c];
#pragma unroll
            for (int w = 0; w < 8; ++w) s += red[(w * 17 + m) * 64 + c];
            mod[((size_t)l * 17 + m) * NMOD + n0 + c] = s;
        }
        __syncthreads();
    }
}

__device__ __forceinline__ void norm_rows(int l, int which, bool first, int mode, const int wid, int b0 = 0, int nb = 0) {
    KArgs a = kargs(); unsigned char* ws = a->ws;
    if (nb == 0) nb = gridDim.x;
    const int tid_ = opaque_tid(wid), lane = tid_ & 63, gw = ((int)blockIdx.x - b0) * 8 + wid, NGW = nb * 8;
    const float* inL = first ? a->in[0] : a->out; const float* inC = first ? a->in[2] : (const float*)(ws + WS_XC);
    const float* gain = a->in[which == 0 ? 6 : (which == 1 ? 9 : 18)] + l * D;
    const float* modl = (const float*)(ws + WS_MOD) + (size_t)l * 17 * NMOD; const int sidx = 3 * which;
    bf16_t* U = (bf16_t*)(ws + WS_U);
    f32x4 gn[4];
#pragma unroll
    for (int j = 0; j < 4; ++j) gn[j] = *(const f32x4*)(gain + 4 * lane + 256 * j);
    const int nrows = mode == 1 ? NBATCH * SEQ : (mode == 2 ? NBATCH * CTX : MT);
    for (int r0 = gw; r0 < nrows; r0 += 2 * NGW) {
        const float* src[2]; const float* sh[2]; int rr[2]; bool ok[2];
        f32x4 v[2][4];
#pragma unroll
        for (int q = 0; q < 2; ++q) {
            const int rq = r0 + q * NGW; ok[q] = rq < nrows; const int rc = ok[q] ? rq : r0;
            const int r = mode == 1 ? (rc >> 11) * TB + CTX + (rc & 2047) : (mode == 2 ? (rc >> 8) * TB + (rc & 255) : rc);
            const int b = r / TB, t = r - b * TB; rr[q] = r;
            src[q] = t < CTX ? inC + ((size_t)b * CTX + t) * D : inL + ((size_t)b * SEQ + t - CTX) * D;
            sh[q] = modl + (size_t)(t < CTX ? 16 : b) * NMOD + sidx * D;
#pragma unroll
            for (int j = 0; j < 4; ++j) v[q][j] = *(const f32x4*)(src[q] + 4 * lane + 256 * j);
        }
#pragma unroll
        for (int q = 0; q < 2; ++q) {
            float ss = 0.f;
#pragma unroll
            for (int j = 0; j < 4; ++j) ss += (v[q][j].x * v[q][j].x + v[q][j].y * v[q][j].y) + (v[q][j].z * v[q][j].z + v[q][j].w * v[q][j].w);
            const float rstd = 1.0f / sqrtf(wave_sum(ss, lane) * (1.0f / D) + EPS);
            if (ok[q]) {
                bf16_t* dst = U + (size_t)rr[q] * D; const float* sc = sh[q] + D;
#pragma unroll
                for (int j = 0; j < 4; ++j) {
                    const f32x4 s1 = *(const f32x4*)(sc + 4 * lane + 256 * j), s0 = *(const f32x4*)(sh[q] + 4 * lane + 256 * j);
                    const f32x4 y = (v[q][j] * rstd * gn[j]) * (s1 + 1.0f) + s0;
                    u32x2 w; w.x = cvt_pk_bf16(y.x, y.y); w.y = cvt_pk_bf16(y.z, y.w);
                    *(u32x2*)(dst + 4 * lane + 256 * j) = w;
                }
            }
        }
    }
}

__device__ __forceinline__ void qk_post(int l, const int wid) {
    KArgs a = kargs(); bf16_t* PROJ = (bf16_t*)(a->ws + WS_BIG);
    const int tid_ = opaque_tid(wid), lane = tid_ & 63, gw = blockIdx.x * 8 + wid, NGW = gridDim.x * 8;
    const int sub = lane >> 5, i = lane & 31;
    const float* qn = a->in[11] + l * 64; const float* kn = a->in[12] + l * 64;
    const float gq0 = qn[2 * i], gq1 = qn[2 * i + 1], gk0 = kn[2 * i], gk1 = kn[2 * i + 1];
    const float freq = fexp2(-(float)(i & 15) * (13.287712379549449f / 16.0f)) * 0.15915494309189535f;
    for (int r0 = gw; r0 < MT; r0 += 4 * NGW) {
        unsigned wv[4][5];
#pragma unroll
        for (int q = 0; q < 4; ++q) { const int rq = r0 + q * NGW; const int rc = rq < MT ? rq : r0; const unsigned* rowp = (const unsigned*)(PROJ + (size_t)rc * PW);
#pragma unroll
            for (int itx = 0; itx < 5; ++itx) wv[q][itx] = rowp[(2 * itx + sub) * 32 + i]; }
#pragma unroll
        for (int q = 0; q < 4; ++q) {
            const int r = r0 + q * NGW;
            if (r < MT) {
                const int b = r / TB, t = r - b * TB;
                float cs_ = 1.f, sn_ = 0.f;
                if (t >= CTX) { const int pos = t - CTX; const float p = (float)(i < 16 ? (pos >> 6) : (pos & 63)); const float rev = p * freq; const float fr_ = rev - floorf(rev); cs_ = cos_rev(fr_); sn_ = sin_rev(fr_); }
                unsigned* rowp = (unsigned*)(PROJ + (size_t)r * PW);
#pragma unroll
                for (int itx = 0; itx < 5; ++itx) {
                    const int hd = 2 * itx + sub;
                    const unsigned w = wv[q][itx]; const float x0 = bflo(w), x1 = bfhi(w);
                    float ss = x0 * x0 + x1 * x1;
#pragma unroll
                    for (int o = 1; o < 32; o <<= 1) ss += shx(ss, o, lane);
                    const float rstd = 1.0f / sqrtf(ss * (1.0f / 64.0f) + EPS);
                    const bool isk = hd < 2;
                    const float y0 = x0 * rstd * (isk ? gk0 : gq0), y1 = x1 * rstd * (isk ? gk1 : gq1);
                    const float sc = isk ? 1.0f : QSCALE;
                    rowp[hd * 32 + i] = cvt_pk_bf16((y0 * cs_ - y1 * sn_) * sc, (y0 * sn_ + y1 * cs_) * sc);
                }
            }
        }
    }
}

__device__ __forceinline__ void final_norm(const int wid) {
    KArgs a = kargs(); float* XL = a->out; const float* gain = a->in[21];
    const int tid_ = opaque_tid(wid), lane = tid_ & 63, gw = blockIdx.x * 8 + wid, NGW = gridDim.x * 8;
    f32x4 gn[4];
#pragma unroll
    for (int j = 0; j < 4; ++j) gn[j] = *(const f32x4*)(gain + 4 * lane + 256 * j);
    for (int r = gw; r < NBATCH * SEQ; r += 2 * NGW) {
        float* row0 = XL + (size_t)r * D; const bool ok1 = r + NGW < NBATCH * SEQ; float* row1 = XL + (size_t)(ok1 ? r + NGW : r) * D;
        f32x4 v[4], u[4]; float ss = 0.f, su = 0.f;
#pragma unroll
        for (int j = 0; j < 4; ++j) { v[j] = *(const f32x4*)(row0 + 4 * lane + 256 * j); u[j] = *(const f32x4*)(row1 + 4 * lane + 256 * j); }
#pragma unroll
        for (int j = 0; j < 4; ++j) { ss += (v[j].x * v[j].x + v[j].y * v[j].y) + (v[j].z * v[j].z + v[j].w * v[j].w); su += (u[j].x * u[j].x + u[j].y * u[j].y) + (u[j].z * u[j].z + u[j].w * u[j].w); }
        const float rstd = 1.0f / sqrtf(wave_sum(ss, lane) * (1.0f / D) + EPS), rstu = 1.0f / sqrtf(wave_sum(su, lane) * (1.0f / D) + EPS);
#pragma unroll
        for (int j = 0; j < 4; ++j) *(f32x4*)(row0 + 4 * lane + 256 * j) = v[j] * rstd * gn[j];
        if (ok1) {
#pragma unroll
            for (int j = 0; j < 4; ++j) *(f32x4*)(row1 + 4 * lane + 256 * j) = u[j] * rstu * gn[j];
        }
    }
}

__device__ __forceinline__ void ph_ffn_in(int which, int lat, LAS unsigned char* lds, const int wid) {
    KArgs a = kargs(); unsigned char* ws = a->ws;
    pg8::Gemm g{(const bf16_t*)(ws + WS_U), (const bf16_t*)(ws + (which ? W_FFN2_IN : W_FFN1_IN)), MT, 2 * DFF, D}; pg8::StaticOrder S; S.init(MT, 2 * DFF, gridDim.x, blockIdx.x, lat);
    EpiSwiglu E{(bf16_t*)(ws + WS_BIG)};
    pg8::gemm_phase(lds, g, S, E, wid);
}
__device__ __forceinline__ void ph_resid(int l, int which  , bool first, int mode, LAS unsigned char* lds, const int wid) {
    KArgs a = kargs(); unsigned char* ws = a->ws;
    const bf16_t* A = (const bf16_t*)(ws + (which == 1 ? WS_U : WS_BIG));
    const bf16_t* Bt = (const bf16_t*)(ws + (which == 0 ? W_FFN1_OUT : (which == 1 ? W_O : W_FFN2_OUT)));
    pg8::Gemm g{A, Bt, MT, D, which == 1 ? D : DFF};
    float* XL = a->out; float* XC = (float*)(ws + WS_XC);
    const float* modl = (const float*)(ws + WS_MOD) + (size_t)l * 17 * NMOD;
    EpiResid E{first ? a->in[0] : XL, first ? a->in[2] : XC, XL, XC, modl + (which == 0 ? 2 : (which == 1 ? 5 : 8)) * D, which == 1 ? 1.0f : 0.5f};
    if (mode == 2) { pg8::OneUnit S{9 * ((int)blockIdx.x >> 2), (int)blockIdx.x & 3}; pg8::gemm_phase(lds, g, S, E, wid); }
    else { pg8::StaticOrder S; S.init(MT, D, gridDim.x, blockIdx.x, mode); pg8::gemm_phase(lds, g, S, E, wid); }
}
__device__ __forceinline__ void ph_inproj(LAS unsigned char* lds, const int wid) {
    KArgs a = kargs(); unsigned char* ws = a->ws;
    pg8::Gemm g{(const bf16_t*)(ws + WS_U), (const bf16_t*)(ws + W_INP), MT, NPROJ, D}; pg8::StaticOrder S; S.init(MT, NPROJ, gridDim.x, blockIdx.x);
    EpiInProj E{(bf16_t*)(ws + WS_PQT), (bf16_t*)(ws + WS_PQTC), (bf16_t*)(ws + WS_VTG), (bf16_t*)(ws + WS_VTN), (bf16_t*)(ws + WS_BIG)};
    pg8::gemm_phase(lds, g, S, E, wid);
}
__device__ __forceinline__ void ph_gates(int lat, LAS unsigned char* lds, const int wid) {
    KArgs a = kargs(); unsigned char* ws = a->ws;
    pg8::Gemm g{(const bf16_t*)(ws + WS_U), (const bf16_t*)(ws + W_GATE), MT, NGATE, D}; pg8::StaticOrder S; S.init(MT, NGATE, gridDim.x, blockIdx.x, lat);
    EpiGates E{(bf16_t*)(ws + WS_BIG)};
    pg8::gemm_phase(lds, g, S, E, wid);
}
template <int BR> __device__ __forceinline__ void ph_merge(int lat, LAS unsigned char* lds, const int wid) {
    KArgs a = kargs(); unsigned char* ws = a->ws;
    pg8::StaticOrder S; S.init(MT, D, gridDim.x, blockIdx.x, lat);
    const bf16_t* A = (const bf16_t*)(ws + (BR == 0 ? WS_YF : (BR == 1 ? WS_YG : WS_YN)));
    const bf16_t* Bt = (const bf16_t*)(ws + (BR == 0 ? W_FOUR : (BR == 1 ? W_GQAO : W_NAO)));
    pg8::Gemm g{A, Bt, MT, D, BR == 1 ? 512 : 256};
    EpiMerge<BR == 0> E{(const bf16_t*)(ws + WS_BIG) + BR * D, (bf16_t*)(ws + WS_U)};
    pg8::gemm_phase(lds, g, S, E, wid);
}
__device__ __forceinline__ void ph_dft(int item, bool ctx, LAS unsigned char* lds, const int wid) {
    KArgs a = kargs(); unsigned char* ws = a->ws;
    if (!ctx) { pg8::Gemm g{(const bf16_t*)(ws + WS_DFT), (const bf16_t*)(ws + WS_PQT), 2048, 4096, 4096}; pg8::OneUnit S{item & 7, item >> 3}; EpiDft E{(bf16_t*)(ws + WS_YF), CTX, 1.0f / 362.03867196751236f};
        pg8::gemm_phase(lds, g, S, E, wid); }
    else { pg8::Gemm g{(const bf16_t*)(ws + WS_DFTC), (const bf16_t*)(ws + WS_PQTC), 256, 4096, 512}; pg8::OneUnit S{0, item}; EpiDft E{(bf16_t*)(ws + WS_YF), 0, 1.0f / 128.0f};
        pg8::gemm_phase(lds, g, S, E, wid); }
}
__device__ __forceinline__ void ph_mixers(int l, LAS unsigned char* lds, const int wid) {
    const int n_dft = 128, n_gl = 1024, n_nl = 512, n_dc = (l == 0) ? 16 : 0, n_gc = (l == 0) ? 128 : 0, n_nc = (l == 0) ? 64 : 0;
    const int total = n_dft + n_gl + n_nl + n_dc + n_gc + n_nc;
    LAS int* qslot = (LAS int*)(lds + LDS_RING);
    { const float* rp = kargs()->in[13] + (size_t)l * 4 * 465; LAS float* T = (LAS float*)(lds + LDS_RPB);
      for (int i = opaque_tid(wid); i < 4 * 15 * 32; i += 512) { const int c = i & 31, hr = i >> 5; T[i] = c < 31 ? rp[hr * 31 + c] * LOG2E : 0.f; }
      __syncthreads(); }
    for (;;) {
        KArgs a = kargs(); unsigned char* ws = a->ws;
        if (opaque_tid(wid) == 0) *qslot = (int)atomicAdd((unsigned*)(ws + WS_CTL) + 64 * l, 1u);
        __syncthreads();
        int item = __builtin_amdgcn_readfirstlane(*qslot);
        __syncthreads();
        if (item >= total) break;
        const bf16_t* PROJ = (const bf16_t*)(ws + WS_BIG); const bf16_t* VTG = (const bf16_t*)(ws + WS_VTG); const bf16_t* VTN = (const bf16_t*)(ws + WS_VTN);
        bf16_t* YG = (bf16_t*)(ws + WS_YG); bf16_t* YN = (bf16_t*)(ws + WS_YN);
        const float* rpb = a->in[13] + (size_t)l * 4 * 465;
        if (item < n_dft) { ph_dft(item, false, lds, wid); continue; }
        item -= n_dft;
        if (item < n_gl) { const int b = item >> 6, kvh = (item >> 5) & 1, qt = item & 31;
            attn_unit<1, false>(lds, PROJ, b, CTX + 64 * qt, 128 + kvh * 256, kvh * 64, VTG + (size_t)(b * 2 + kvh) * 64 * TB, 4, 36, YG, 512, kvh * 256, rpb, 0, wid); continue; }
        item -= n_gl;
        if (item < n_nl) { const int b = item >> 5, r = item & 31, rs = min(max(r - 4, 0), 24);
            attn_unit<4, true>(lds, PROJ, b, CTX + 64 * r, 640, 896, VTN + (size_t)(b * 4) * 64 * TB, 4 + rs, 12 + rs, YN, 256, 0, rpb, r, wid); continue; }
        item -= n_nl;
        if (item < n_dc) { ph_dft(item, true, lds, wid); continue; }
        item -= n_dc;
        if (item < n_gc) { const int b = item >> 3, kvh = (item >> 2) & 1, qt = item & 3;
            attn_unit<1, false>(lds, PROJ, b, 64 * qt, 128 + kvh * 256, kvh * 64, VTG + (size_t)(b * 2 + kvh) * 64 * TB, 4, 4, YG, 512, kvh * 256, rpb, 0, wid); continue; }
        item -= n_gc;
        { const int b = item >> 2, qt = item & 3;
            attn_unit<4, false>(lds, PROJ, b, 64 * qt, 640, 896, VTN + (size_t)(b * 4) * 64 * TB, 4, 4, YN, 256, 0, rpb, 0, wid); }
    }
}

#define XB_TMO      128
#define XB_XCNT(j)  (256  + 64 * (j))
#define XB_XSUB(j)  (1280 + 64 * (j))
#define XB_XGEN(j)  (2304 + 64 * (j))
#define XB_TOP      3328
#define XB_TOPGEN   3392
#define XCD_BAR_WORDS 3456
#define XB_SPIN_CAP (1u << 22)
constexpr int CW_BAR = 1024;
__device__ __forceinline__ unsigned xb_ld(unsigned* p)              { return __hip_atomic_load(p, __ATOMIC_RELAXED, __HIP_MEMORY_SCOPE_AGENT); }
__device__ __forceinline__ unsigned xb_add(unsigned* p, unsigned v) { return __hip_atomic_fetch_add(p, v, __ATOMIC_RELAXED, __HIP_MEMORY_SCOPE_AGENT); }
__device__ __forceinline__ unsigned xb_xcc_id() { return (unsigned)__builtin_amdgcn_s_getreg((3 << 11) | 20) & 0xFu; }
#define XB_SPIN(cond, bar) do { unsigned _sp = 0; while (cond) { __builtin_amdgcn_s_sleep(1); \
    if ((++_sp & 255u) == 0u) { if (xb_ld(&(bar)[XB_TMO])) break; if (_sp > XB_SPIN_CAP) { atomicAdd(&(bar)[XB_TMO], 1u); break; } } } } while (0)
__device__ __forceinline__ void xcd_barrier_complete(unsigned* bar, unsigned x, unsigned& nloc, unsigned& nx) {
    const unsigned G = gridDim.x;
    unsigned sum, cnt, mine, sp = 0u;
    for (;;) {
        sum = 0u; cnt = 0u; mine = 0u;
#pragma unroll
        for (unsigned j = 0; j < 16; ++j) { const unsigned c = xb_ld(&bar[XB_XCNT(j)]); sum += c; cnt += (c > 0u) ? 1u : 0u; mine = (j == x) ? c : mine; }
        if (sum == G) break;
        __builtin_amdgcn_s_sleep(1);
        if ((++sp & 255u) == 0u) { if (xb_ld(&bar[XB_TMO])) break; if (sp > XB_SPIN_CAP) { atomicAdd(&bar[XB_TMO], 1u); break; } }
    }
    nloc = mine > 0u ? mine : 1u; nx = cnt > 0u ? cnt : 1u;
}
__device__ __forceinline__ void gsync(LAS unsigned char* lds, const int wid) {
    asm volatile("s_waitcnt vmcnt(0)" ::: "memory");
    __syncthreads();
    if (opaque_tid(wid) == 0) {
        unsigned* bar = (unsigned*)(kargs()->ws + WS_CTL) + CW_BAR;
        volatile LAS unsigned* st = (volatile LAS unsigned*)(lds + LDS_RING + 64);
        const unsigned x = xb_xcc_id();
        __builtin_amdgcn_s_waitcnt(0);
        unsigned nloc = st[0], nx = st[1];
        if (nloc == 0u) { xcd_barrier_complete(bar, x, nloc, nx); st[0] = nloc; st[1] = nx; }
        const unsigned old = xb_add(&bar[XB_XSUB(x)], 1u);
        const unsigned gen = old / nloc;
        if (old + 1u == (gen + 1u) * nloc) {
            __builtin_amdgcn_fence(__ATOMIC_RELEASE, "agent");
            asm volatile("s_waitcnt vmcnt(0)" ::: "memory");
            const unsigned og = xb_add(&bar[XB_TOP], 1u);
            const unsigned tg = og / nx;
            if (og + 1u == (tg + 1u) * nx) xb_add(&bar[XB_TOPGEN], 1u);
            else XB_SPIN(xb_ld(&bar[XB_TOPGEN]) == tg, bar);
            __builtin_amdgcn_fence(__ATOMIC_ACQUIRE, "agent");
            xb_add(&bar[XB_XGEN(x)], 1u);
            asm volatile("s_waitcnt vmcnt(0)" ::: "memory");
        } else {
            XB_SPIN(xb_ld(&bar[XB_XGEN(x)]) == gen, bar);
            __builtin_amdgcn_fence(__ATOMIC_ACQUIRE, "agent");
            asm volatile("s_waitcnt vmcnt(0)" ::: "memory");
        }
    }
    __syncthreads();
}

__device__ __forceinline__ void subsync(int word, unsigned n, const int wid) {
    asm volatile("s_waitcnt vmcnt(0)" ::: "memory");
    __syncthreads();
    if (opaque_tid(wid) == 0) {
        unsigned* w = (unsigned*)(kargs()->ws + WS_CTL) + 512 + 64 * word;
        __builtin_amdgcn_fence(__ATOMIC_RELEASE, "agent");
        asm volatile("s_waitcnt vmcnt(0)" ::: "memory");
        xb_add(w, 1u);
        while (xb_ld(w) < n) __builtin_amdgcn_s_sleep(2);
        __builtin_amdgcn_fence(__ATOMIC_ACQUIRE, "agent");
        asm volatile("s_waitcnt vmcnt(0)" ::: "memory");
    }
    __syncthreads();
}
__device__ __forceinline__ void seam_x(int l, int which, bool first, int seam, LAS unsigned char* lds, const int wid) {
    if (blockIdx.x < 64) { ph_resid(l, which, first, 2, lds, wid); subsync(seam, 64u, wid); norm_rows(l, which + 1, false, 2, wid, 0, 64); }
    else norm_rows(l, which + 1, false, 1, wid, 64, (int)gridDim.x - 64);
}

__device__ __forceinline__ void seam_layer(LAS unsigned char* lds, const int wid) {
    if (blockIdx.x < 64) { ph_resid(0, 2, false, 2, lds, wid); subsync(3, 64u, wid); norm_rows(1, 0, false, 2, wid, 0, 64); }
    else { convert_weights(1, lds, wid, 64, (int)gridDim.x - 64, 1); norm_rows(1, 0, false, 1, wid, 64, (int)gridDim.x - 64); }
}

template <int l> __device__ __forceinline__ void layer_body(LAS unsigned char* lds, const int wid) {
        const int lat = l;
        if (l == 0) { norm_rows(0, 0, true, 0, wid); gsync(lds, wid); }
        if (l == 1) { convert_weights(1, lds, wid, 0, 0, 2); __syncthreads(); }
        ph_ffn_in(0, 0, lds, wid);
        gsync(lds, wid);
        ph_resid(l, 0, l == 0, 1, lds, wid);
        gsync(lds, wid);
        seam_x(l, 0, l == 0, l, lds, wid);
        gsync(lds, wid);
        ph_inproj(lds, wid);
        gsync(lds, wid);
        qk_post(l, wid);
        gsync(lds, wid);
        ph_mixers(l, lds, wid);
        gsync(lds, wid);
        ph_gates(lat, lds, wid);
        gsync(lds, wid);
        ph_merge<0>(lat, lds, wid); ph_merge<1>(lat, lds, wid); ph_merge<2>(lat, lds, wid);
        gsync(lds, wid);
        ph_resid(l, 1, false, 1, lds, wid);
        gsync(lds, wid);
        if (l == 0) seam_x(l, 1, false, 2, lds, wid);
        else norm_rows(l, 2, false, 1, wid);
        gsync(lds, wid);
        ph_ffn_in(1, lat, lds, wid);
        gsync(lds, wid);
        ph_resid(l, 2, false, 1, lds, wid);
        gsync(lds, wid);
        if (l == 0) { seam_layer(lds, wid); gsync(lds, wid); }
}

__global__ void __launch_bounds__(512, 2) mega_fwd(Args a_unused) {
    extern __shared__ __attribute__((aligned(16))) unsigned char lds_raw[];
    LAS unsigned char* lds = (LAS unsigned char*)lds_raw;
    const int wid = __builtin_amdgcn_readfirstlane((int)threadIdx.x >> 6);
    if (threadIdx.x < 16) ((LAS unsigned*)(lds + LDS_RING))[threadIdx.x + 16] = 0u;
    if (threadIdx.x == 0) (void)xb_add((unsigned*)(kargs()->ws + WS_CTL) + CW_BAR + XB_XCNT(xb_xcc_id()), 1u);
    if (kargs()->dbg == 0x7fffffff) cg::this_grid().sync();
    __syncthreads();
    convert_weights(0, lds, wid);
    dft_tables(wid);
    __syncthreads();
    mod_vectors(lds, wid);
    gsync(lds, wid);
    layer_body<0>(lds, wid);
    layer_body<1>(lds, wid);
    final_norm(wid);
}

extern "C" void kernel_launch(void* const* d_in, const int* in_sizes, int n_in, void* d_out, int out_size, void* d_ws, size_t ws_size, hipStream_t stream) {
    static int grid = 0;
    if (grid == 0) {
        if (n_in != 22 || ws_size < WS_END) { fprintf(stderr, "kernel_launch: need 22 inputs and %zu bytes of workspace (got %d, %zu)\n", (size_t)WS_END, n_in, ws_size); grid = -1; return; }
        int dev = 0, cus = 0, per_cu = 0;
        (void)hipGetDevice(&dev);
        (void)hipDeviceGetAttribute(&cus, hipDeviceAttributeMultiprocessorCount, dev);
        if (hipFuncSetAttribute((const void*)mega_fwd, hipFuncAttributeMaxDynamicSharedMemorySize, LDS_BYTES) != hipSuccess) { fprintf(stderr, "kernel_launch: hipFuncSetAttribute failed\n"); grid = -1; return; }
        if (hipOccupancyMaxActiveBlocksPerMultiprocessor(&per_cu, (const void*)mega_fwd, 512, LDS_BYTES) != hipSuccess || per_cu < 1) { fprintf(stderr, "kernel_launch: occupancy query failed (%d)\n", per_cu); per_cu = 1; }
        (void)hipGetLastError();
        grid = cus * 1;
    }
    if (grid < 0) return;
    (void)hipMemsetAsync((char*)d_ws + WS_CTL, 0, 32768, stream);
    Args a{};
    for (int i = 0; i < 22; ++i) a.in[i] = (const float*)d_in[i];
    a.out = (float*)d_out; a.ws = (unsigned char*)d_ws; a.dbg = DBG; a.pad = 0;
    void* args[] = {&a};
    hipError_t e = hipLaunchCooperativeKernel((const void*)mega_fwd, dim3(grid), dim3(512), args, LDS_BYTES, stream);
    if (e != hipSuccess) fprintf(stderr, "cooperative launch failed: %s (grid %d)\n", hipGetErrorString(e), grid);
}
```
